# Optimizing an MI355X kernel written in HIP

```python
import jax, jax.numpy as jnp
from jax import lax
import numpy as np

D_MODEL = 2048
BATCH = 4
SEQ = 2048
DEPTH = 4

N_META = 16
SB_HEADS = 8
SB_HEAD_DIM = D_MODEL // 16
SB_WIDTH = SB_HEADS * SB_HEAD_DIM
POOL_WINDOWS = (2, 4, 8, 16)
POOL_GROUPS = len(POOL_WINDOWS)
POOL_WIDTH = D_MODEL // 2
POOL_GROUP_DIM = POOL_WIDTH // POOL_GROUPS
Q_BLOCK = 128
RMS_EPS = 1e-6
IN_SIZES = (SB_WIDTH, SB_WIDTH, SB_WIDTH, SB_WIDTH, POOL_WIDTH, POOL_WIDTH, D_MODEL, D_MODEL)
IN_COLS = sum(IN_SIZES)

kernel_name = "hybrid_stickbreak_pool_gated_trunk"


def rmsnorm(x, gain):
    xf = x.astype(jnp.float32)
    y = xf * lax.rsqrt(jnp.mean(xf * xf, axis=-1, keepdims=True) + RMS_EPS)
    return (y * gain.astype(jnp.float32)).astype(x.dtype)


def stick_breaking_block(q_blk, k_pre, v_pre, q0):
    nq = q_blk.shape[1]
    nk = k_pre.shape[1]
    z = jnp.einsum('bqhd,bkhd->bhqk', q_blk.astype(jnp.float32), k_pre.astype(jnp.float32)) * (SB_HEAD_DIM ** -0.5)
    qpos = q0 + jnp.arange(nq)
    kpos = jnp.arange(nk)
    causal = kpos[None, :] < qpos[:, None]
    log_1m_beta = jnp.where(causal, jax.nn.log_sigmoid(-z), 0.0)
    between = lax.cumsum(log_1m_beta, axis=3, reverse=True) - log_1m_beta
    a = jnp.where(causal, jnp.exp(jax.nn.log_sigmoid(z) + between), 0.0)
    o = jnp.einsum('bhqk,bkhd->bqhd', a, v_pre.astype(jnp.float32))
    return o


def stick_breaking_attention(q, k, v):
    L = q.shape[1]
    bounds = [(0, N_META)] + [(s, min(s + Q_BLOCK, L)) for s in range(N_META, L, Q_BLOCK)]
    outs = [stick_breaking_block(q[:, s:e], k[:, :e], v[:, :e], s) for (s, e) in bounds]
    return jnp.concatenate(outs, axis=1)


def multiscale_pool(u):
    L = u.shape[1]
    wmax = max(POOL_WINDOWS)
    c = jnp.cumsum(jnp.pad(u, ((0, 0), (wmax, 0), (0, 0))), axis=1)
    steps = jnp.arange(1, L + 1, dtype=jnp.float32)[None, :, None]
    outs = []
    for g, w in enumerate(POOL_WINDOWS):
        sl = slice(g * POOL_GROUP_DIM, (g + 1) * POOL_GROUP_DIM)
        win_sum = c[:, wmax:, sl] - c[:, wmax - w:wmax - w + L, sl]
        cnt = jnp.minimum(steps, float(w))
        outs.append(win_sum / cnt - u[:, :, sl])
    return jnp.stack(outs, axis=2)


def hybrid_layer(x, gain, w_in, pool_w, pool_scale, w_attn_up, w_pool_up, w_out):
    B, L, _ = x.shape
    h = rmsnorm(x, gain)
    zin = h @ w_in.astype(h.dtype)
    cuts = np.cumsum(IN_SIZES)[:-1].tolist()
    q, k, v, g_attn, u, g_pool, m_attn, m_pool = jnp.split(zin, cuts, axis=-1)
    q = q.reshape(B, L, SB_HEADS, SB_HEAD_DIM)
    k = k.reshape(B, L, SB_HEADS, SB_HEAD_DIM)
    v = v.reshape(B, L, SB_HEADS, SB_HEAD_DIM)
    o_attn = stick_breaking_attention(q, k, v).reshape(B, L, SB_WIDTH)
    o_attn = (o_attn * jax.nn.silu(g_attn.astype(jnp.float32))).astype(x.dtype)
    y_attn = o_attn @ w_attn_up.astype(x.dtype)
    pooled = multiscale_pool(u.astype(jnp.float32))
    mixed = jnp.einsum('blgc,gcd->blgd', pooled, pool_w.astype(jnp.float32)).reshape(B, L, POOL_WIDTH)
    o_pool = (mixed * pool_scale.astype(jnp.float32) * jax.nn.silu(g_pool.astype(jnp.float32))).astype(x.dtype)
    y_pool = o_pool @ w_pool_up.astype(x.dtype)
    merged = jax.nn.sigmoid(m_attn) * y_attn + jax.nn.sigmoid(m_pool) * y_pool
    return x + merged @ w_out.astype(x.dtype)


def setup_inputs(seed: int = 0) -> dict:
    key = jax.random.key(seed)
    ks = jax.random.split(key, 10)
    f32 = jnp.float32
    x = jax.random.normal(ks[0], (BATCH, SEQ, D_MODEL), f32)
    meta_tokens = jax.random.normal(ks[1], (N_META, D_MODEL), f32)
    norm_gain = 1.0 + 0.02 * jax.random.normal(ks[2], (DEPTH, D_MODEL), f32)
    w_in = jax.random.normal(ks[3], (DEPTH, D_MODEL, IN_COLS), f32) * D_MODEL ** -0.5
    pool_w = jax.random.normal(ks[4], (DEPTH, POOL_GROUPS, POOL_GROUP_DIM, POOL_GROUP_DIM), f32) * POOL_GROUP_DIM ** -0.5
    pool_scale = 1.0 + 0.1 * jax.random.normal(ks[5], (DEPTH, POOL_WIDTH), f32)
    w_attn_up = jax.random.normal(ks[6], (DEPTH, SB_WIDTH, D_MODEL), f32) * SB_WIDTH ** -0.5
    w_pool_up = jax.random.normal(ks[7], (DEPTH, POOL_WIDTH, D_MODEL), f32) * POOL_WIDTH ** -0.5
    w_out = jax.random.normal(ks[8], (DEPTH, D_MODEL, D_MODEL), f32) * D_MODEL ** -0.5
    final_gain = 1.0 + 0.02 * jax.random.normal(ks[9], (D_MODEL,), f32)
    return {"x": x, "meta_tokens": meta_tokens, "norm_gain": norm_gain, "w_in": w_in,
            "pool_w": pool_w, "pool_scale": pool_scale, "w_attn_up": w_attn_up,
            "w_pool_up": w_pool_up, "w_out": w_out, "final_gain": final_gain}


def reference(x, meta_tokens, norm_gain, w_in, pool_w, pool_scale, w_attn_up, w_pool_up, w_out, final_gain):
    B = x.shape[0]
    meta = jnp.broadcast_to(meta_tokens.astype(x.dtype)[None], (B, N_META, x.shape[2]))
    hs = jnp.concatenate([meta, x], axis=1)
    for layer in range(DEPTH):
        hs = hybrid_layer(hs, norm_gain[layer], w_in[layer], pool_w[layer], pool_scale[layer],
                          w_attn_up[layer], w_pool_up[layer], w_out[layer])
    return rmsnorm(hs, final_gain)[:, N_META:]
```

```cpp
#include <hip/hip_runtime.h>
#include <hip/hip_cooperative_groups.h>
#include <cstdio>
#include <cstdint>
namespace cg = cooperative_groups;

#ifndef MK_MULTI
#define MK_MULTI 0
#endif

#define LAS __attribute__((address_space(3)))
typedef unsigned short bf16_t;
typedef short bf16x8 __attribute__((ext_vector_type(8)));
typedef short s16x4 __attribute__((ext_vector_type(4)));
typedef float f32x4 __attribute__((ext_vector_type(4)));
typedef unsigned u32x4 __attribute__((ext_vector_type(4)));
typedef unsigned u32x2 __attribute__((ext_vector_type(2)));

constexpr int DM = 2048, NB = 4, SEQ = 2048, DEPTH = 4, NMETA = 16, NH = 8, DH = 128, SBW = 1024, PWD = 1024, GD = 256, INC = 10240;
constexpr int MREAL = NB * SEQ;
constexpr int MROWS = MREAL + NB * NMETA;
constexpr int MPAD = 8448;
constexpr int LP = 2176;
constexpr int TOFF = 48;
constexpr float RMS_EPS = 1e-6f;
constexpr float LOG2E = 1.4426950408889634f;
constexpr float QSCALE = 0.08838834764831845f * LOG2E;

constexpr size_t al256(size_t x) { return (x + 255) & ~(size_t)255; }
constexpr size_t WS_CTL = 0;
constexpr size_t WS_XS = 4096;
constexpr size_t WS_HB = al256(WS_XS + (size_t)MPAD * DM * 4);
constexpr size_t WS_WIN = al256(WS_HB + (size_t)MPAD * DM * 2);
constexpr size_t WS_WM = al256(WS_WIN + (size_t)DEPTH * INC * DM * 2);
constexpr size_t WS_WO = al256(WS_WM + (size_t)DEPTH * DM * DM * 2);
constexpr size_t WS_PW = al256(WS_WO + (size_t)DEPTH * DM * DM * 2);
constexpr size_t WS_QB = al256(WS_PW + (size_t)DEPTH * 4 * GD * GD * 2);
constexpr size_t WS_KB = al256(WS_QB + (size_t)MPAD * 1024 * 2);
constexpr size_t WS_VB = al256(WS_KB + (size_t)NB * LP * 1024 * 2);
constexpr size_t WS_UB = al256(WS_VB + (size_t)NB * LP * 1024 * 2);
constexpr size_t WS_GA = al256(WS_UB + (size_t)NB * LP * 1024 * 2);
constexpr size_t WS_GP = al256(WS_GA + (size_t)MPAD * 1024 * 2);
constexpr size_t WS_SMA = al256(WS_GP + (size_t)MPAD * 1024 * 2);
constexpr size_t WS_SMP = al256(WS_SMA + (size_t)MPAD * DM * 2);
constexpr size_t WS_OAP = al256(WS_SMP + (size_t)MPAD * DM * 2);
constexpr size_t WS_PL = al256(WS_OAP + (size_t)MPAD * DM * 2);
constexpr size_t WS_T1 = al256(WS_PL + (size_t)MPAD * 1024 * 2);
constexpr size_t WS_MG = al256(WS_T1 + (size_t)MPAD * DM * 4);
constexpr size_t WS_END = al256(WS_MG + (size_t)MPAD * DM * 2);

constexpr int LDS_BYTES = 147456;
constexpr int RING_BYTES = 131072;
constexpr int MISC_OFF = RING_BYTES;

__device__ __forceinline__ unsigned cvt_pk_bf16(float lo, float hi) { unsigned r; asm volatile("v_cvt_pk_bf16_f32 %0, %1, %2" : "=v"(r) : "v"(lo), "v"(hi)); return r; }
__device__ __forceinline__ int tid_fresh() { int t = threadIdx.x; asm volatile("" : "+v"(t)); return t; }
__device__ __forceinline__ float bf_lo(unsigned w) { return __uint_as_float(w << 16); }
__device__ __forceinline__ float bf_hi(unsigned w) { return __uint_as_float(w & 0xffff0000u); }
__device__ __forceinline__ float fsigmoid(float v) { return __builtin_amdgcn_rcpf(1.0f + __builtin_amdgcn_exp2f(-v * LOG2E)); }
__device__ __forceinline__ float shfl_idx(float v, int srclane) { return __int_as_float(__builtin_amdgcn_ds_bpermute(srclane << 2, __float_as_int(v))); }
__device__ __forceinline__ float wave_sum(float v, int lane) {
#pragma unroll
    for (int o = 1; o < 64; o <<= 1) v += shfl_idx(v, lane ^ o);
    return v;
}
__device__ __forceinline__ int btrow(int row) {
    return row < MREAL ? (row >> 11) * LP + 64 + (row & 2047) : ((row - MREAL) >> 4) * LP + TOFF + ((row - MREAL) & 15);
}

namespace pg8 {
constexpr int BM = 256, BK = 64, HALF = 128, HTB = HALF * BK * 2, STAGE_BYTES = 8 * HTB, NXCD = 8, WGM = 8;
__host__ __device__ __forceinline__ int lds_byte(int r, int c) { const int st = (r >> 4) * 2 + (c >> 5), rr = r & 15, cc = c & 31, ob = rr * 64 + cc * 2; return st * 1024 + (ob ^ (((ob >> 9) & 1) << 5)); }
__host__ __device__ __forceinline__ void stage_rc(int b, int& R, int& C) { const int st = b / 1024, sb = b % 1024, swz = sb ^ (((sb >> 9) & 1) << 5); R = (st >> 1) * 16 + swz / 64; C = (st & 1) * 32 + (swz % 64) / 2; }
__host__ __device__ __forceinline__ int perm32(int rho) { const int n = rho >> 4, i = rho & 15; return 8 * (i >> 2) + 4 * n + (i & 3); }

struct Unit { int pm, pn; };
struct Gemm { const bf16_t* A; const bf16_t* Bt; int lda, ldb, K; };

struct StaticOrder {
    int nM, nN, nwg, G, c;
    __host__ __device__ void init(int M, int N, int G_, int c_) { nM = M / BM; nN = N / BM; nwg = nM * nN; G = G_; c = c_; }
    __host__ __device__ bool next(int i, Unit& u) const {
        const long L = (long)i * G + c; if (L >= nwg) return false;
        int wgid = (int)L; { const int q = nwg / NXCD, r = nwg % NXCD, xcd = wgid % NXCD, off = wgid / NXCD; wgid = (xcd < r ? xcd * (q + 1) : r * (q + 1) + (xcd - r) * q) + off; }
        const int nig = WGM * nN, gid = wgid / nig, fm = gid * WGM, gsz = (nM - fm) < WGM ? (nM - fm) : WGM;
        u.pm = fm + ((wgid % nig) % gsz); u.pn = (wgid % nig) / gsz; return true;
    }
};
struct OneUnit {
    Unit u;
    __device__ bool next(int i, Unit& o) const { if (i) return false; o = u; return true; }
};

template <class Epi, class Sched, bool ALIGN_EPI = true, bool SP2 = true>
__device__ __forceinline__ void gemm_phase(LAS unsigned char* lds, const Gemm g, const Sched& S, const Epi& E) {
    const int tid = tid_fresh(), wid = __builtin_amdgcn_readfirstlane(tid >> 6), lane = tid & 63, wr = wid >> 2, wc = wid & 3, fr = lane & 15, fq = lane >> 4;
    const int K = g.K, nt = K / BK;
    unsigned voffA[2], voffB[2];
#pragma unroll
    for (int i = 0; i < 2; ++i) { int R, C; stage_rc(tid * 16 + i * 8192, R, C); const int Rb = Epi::PERM ? ((R & ~31) + perm32(R & 31)) : R;
        voffA[i] = (unsigned)(R * g.lda + C) * 2u; voffB[i] = (unsigned)(Rb * g.ldb + C) * 2u; }
    const size_t kstep = (size_t)(BK * 2);
    const size_t hstepA = (size_t)HALF * g.lda * 2, hstepB = (size_t)HALF * g.ldb * 2;
    const size_t tstepA = 2 * hstepA, tstepB = 2 * hstepB;
    const unsigned ldsw = (unsigned)wid * 1024u;
    const int aoff = lds_byte(wr * 64 + fr, fq * 8), boff = lds_byte(wc * 32 + fr, fq * 8);
#define PG8_SA(b, h) (((b) * 2 + (h)) * HTB)
#define PG8_SB(b, h) ((4 + (b) * 2 + (h)) * HTB)
#define PG8_STAGE(bufoff, gbase, voff) do { _Pragma("unroll") for (int _i = 0; _i < 2; ++_i) \
        __builtin_amdgcn_global_load_lds((const unsigned*)((const char*)(gbase) + (voff)[_i]), (LAS unsigned*)(lds + (bufoff) + ldsw + _i * 8192), 16, 0, 0); } while (0)
#define PG8_LDA(dst, b, h) do { _Pragma("unroll") for (int m = 0; m < 4; ++m) _Pragma("unroll") for (int k = 0; k < 2; ++k) dst[m][k] = *(const LAS bf16x8*)(lds + PG8_SA(b, h) + aoff + m * 2048 + k * 1024); } while (0)
#define PG8_LDB(dst, b, h) do { _Pragma("unroll") for (int n = 0; n < 2; ++n) _Pragma("unroll") for (int k = 0; k < 2; ++k) dst[n][k] = *(const LAS bf16x8*)(lds + PG8_SB(b, h) + boff + n * 2048 + k * 1024); } while (0)
#define PG8_MMA(ai, bj, At, Bt) do { __builtin_amdgcn_s_setprio(1); _Pragma("unroll") for (int m = 0; m < 4; ++m) _Pragma("unroll") for (int n = 0; n < 2; ++n) _Pragma("unroll") for (int k = 0; k < 2; ++k) \
        acc[ai][bj][m][n] = __builtin_amdgcn_mfma_f32_16x16x32_bf16(Bt[n][k], At[m][k], acc[ai][bj][m][n], 0, 0, 0); __builtin_amdgcn_s_setprio(0); } while (0)
#define PG8_WAIT_V(n) asm volatile("s_waitcnt vmcnt(" #n ")" ::: "memory")
#define PG8_WAIT_L(n) asm volatile("s_waitcnt lgkmcnt(" #n ")" ::: "memory")
#define PG8_BAR __builtin_amdgcn_s_barrier()
#define PG8_SCHED __builtin_amdgcn_sched_barrier(0)
    Unit cur, nxt; int ui = 0;
    if (!S.next(0, cur)) return;
    f32x4 acc[2][2][4][2];
#pragma unroll
    for (int a = 0; a < 2; ++a)
#pragma unroll
        for (int b = 0; b < 2; ++b)
#pragma unroll
            for (int m = 0; m < 4; ++m)
#pragma unroll
                for (int n = 0; n < 2; ++n) acc[a][b][m][n] = (f32x4){0.f, 0.f, 0.f, 0.f};
    bf16x8 At[4][2], B0[2][2], B1[2][2];
    const char* cA = (const char*)g.A + (size_t)cur.pm * tstepA; const char* cB = (const char*)g.Bt + (size_t)cur.pn * tstepB;
    if constexpr (SP2) {
        PG8_STAGE(PG8_SB(0, 0), cB, voffB); PG8_STAGE(PG8_SB(0, 1), cB + hstepB, voffB); PG8_STAGE(PG8_SA(0, 0), cA, voffA); PG8_STAGE(PG8_SA(0, 1), cA + hstepA, voffA);
        if (wr == 1) PG8_BAR;
        PG8_WAIT_V(2); PG8_BAR;
        PG8_STAGE(PG8_SB(1, 0), cB + kstep, voffB); PG8_STAGE(PG8_SA(1, 0), cA + kstep, voffA); PG8_STAGE(PG8_SB(1, 1), cB + hstepB + kstep, voffB);
        PG8_WAIT_V(6); PG8_BAR;
    } else {
        PG8_STAGE(PG8_SB(0, 0), cB, voffB); PG8_STAGE(PG8_SA(0, 0), cA, voffA); PG8_STAGE(PG8_SB(0, 1), cB + hstepB, voffB); PG8_STAGE(PG8_SA(0, 1), cA + hstepA, voffA);
        if (wr == 1) PG8_BAR;
        PG8_WAIT_V(4); PG8_BAR;
        PG8_STAGE(PG8_SB(1, 0), cB + kstep, voffB); PG8_STAGE(PG8_SA(1, 0), cA + kstep, voffA); PG8_STAGE(PG8_SB(1, 1), cB + hstepB + kstep, voffB);
        PG8_WAIT_V(6); PG8_BAR;
    }
    for (;;) {
        const bool has_next = S.next(ui + 1, nxt);
        const char* nA = has_next ? (const char*)g.A + (size_t)nxt.pm * tstepA : cA; const char* nB = has_next ? (const char*)g.Bt + (size_t)nxt.pn * tstepB : cB;
        for (int t = 0; t < nt; t += 2) {
            const bool last = (t == nt - 2);
            const char* a1 = cA + (size_t)(t + 1) * kstep;
            const char* a2 = last ? nA : cA + (size_t)(t + 2) * kstep; const char* b2 = last ? nB : cB + (size_t)(t + 2) * kstep;
            const char* a3 = a2 + kstep; const char* b3 = b2 + kstep;
            if constexpr (SP2) {
            PG8_LDB(B0, 0, 0); PG8_LDB(B1, 0, 1); PG8_SCHED; PG8_LDA(At, 0, 0); PG8_STAGE(PG8_SA(1, 1), a1 + hstepA, voffA);
            PG8_WAIT_V(8); PG8_WAIT_L(0); PG8_BAR; PG8_MMA(0, 0, At, B0); PG8_MMA(0, 1, At, B1); PG8_BAR; PG8_SCHED;
            PG8_LDA(At, 0, 1); PG8_STAGE(PG8_SB(0, 0), b2, voffB); PG8_STAGE(PG8_SB(0, 1), b2 + hstepB, voffB); PG8_STAGE(PG8_SA(0, 0), a2, voffA);
            PG8_WAIT_V(8); PG8_WAIT_L(0); PG8_BAR; PG8_MMA(1, 0, At, B0); PG8_MMA(1, 1, At, B1); PG8_BAR; PG8_SCHED;
            PG8_LDB(B0, 1, 0); PG8_LDB(B1, 1, 1); PG8_SCHED; PG8_LDA(At, 1, 0); PG8_STAGE(PG8_SA(0, 1), a2 + hstepA, voffA);
            PG8_WAIT_V(8); PG8_WAIT_L(0); PG8_BAR; PG8_MMA(0, 0, At, B0); PG8_MMA(0, 1, At, B1); PG8_BAR; PG8_SCHED;
            PG8_LDA(At, 1, 1); PG8_STAGE(PG8_SB(1, 0), b3, voffB); PG8_STAGE(PG8_SB(1, 1), b3 + hstepB, voffB); PG8_STAGE(PG8_SA(1, 0), a3, voffA);
            PG8_WAIT_V(8); PG8_WAIT_L(0); PG8_BAR; PG8_MMA(1, 0, At, B0); PG8_MMA(1, 1, At, B1); PG8_BAR; PG8_SCHED;
            } else {
            PG8_LDB(B0, 0, 0); PG8_SCHED; PG8_LDA(At, 0, 0); PG8_STAGE(PG8_SA(1, 1), a1 + hstepA, voffA);
            PG8_WAIT_L(8); PG8_BAR; PG8_WAIT_L(0); PG8_MMA(0, 0, At, B0); PG8_BAR; PG8_SCHED;
            PG8_LDB(B1, 0, 1); PG8_STAGE(PG8_SB(0, 0), b2, voffB);
            PG8_BAR; PG8_WAIT_L(0); PG8_MMA(0, 1, At, B1); PG8_BAR;
            PG8_LDA(At, 0, 1); PG8_STAGE(PG8_SA(0, 0), a2, voffA);
            PG8_BAR; PG8_WAIT_L(0); PG8_MMA(1, 0, At, B0); PG8_BAR; PG8_SCHED;
            PG8_STAGE(PG8_SB(0, 1), b2 + hstepB, voffB);
            PG8_WAIT_V(6); PG8_BAR; PG8_MMA(1, 1, At, B1); PG8_BAR;
            PG8_LDB(B0, 1, 0); PG8_SCHED; PG8_LDA(At, 1, 0); PG8_STAGE(PG8_SA(0, 1), a2 + hstepA, voffA);
            PG8_WAIT_L(8); PG8_BAR; PG8_WAIT_L(0); PG8_MMA(0, 0, At, B0); PG8_BAR; PG8_SCHED;
            PG8_LDB(B1, 1, 1); PG8_STAGE(PG8_SB(1, 0), b3, voffB);
            PG8_BAR; PG8_WAIT_L(0); PG8_MMA(0, 1, At, B1); PG8_BAR;
            PG8_LDA(At, 1, 1); PG8_STAGE(PG8_SA(1, 0), a3, voffA);
            PG8_BAR; PG8_WAIT_L(0); PG8_MMA(1, 0, At, B0); PG8_BAR; PG8_SCHED;
            PG8_STAGE(PG8_SB(1, 1), b3 + hstepB, voffB);
            PG8_WAIT_V(6); PG8_BAR; PG8_MMA(1, 1, At, B1); PG8_BAR;
            }
        }
        if constexpr (ALIGN_EPI) { if (wr == 0) PG8_BAR; }
        E(acc, cur, wr, wc, fr, fq);
        if (!has_next) break;
#pragma unroll
        for (int a = 0; a < 2; ++a)
#pragma unroll
            for (int b = 0; b < 2; ++b)
#pragma unroll
                for (int m = 0; m < 4; ++m)
#pragma unroll
                    for (int n = 0; n < 2; ++n) acc[a][b][m][n] = (f32x4){0.f, 0.f, 0.f, 0.f};
        cur = nxt; cA = nA; cB = nB; ++ui;
        if constexpr (ALIGN_EPI) { if (wr == 1) PG8_BAR; }
    }
    PG8_WAIT_V(0);
    if constexpr (!ALIGN_EPI) { if (wr == 0) PG8_BAR; }
    PG8_BAR;
#undef PG8_SA
#undef PG8_SB
#undef PG8_STAGE
#undef PG8_LDA
#undef PG8_LDB
#undef PG8_MMA
#undef PG8_WAIT_V
#undef PG8_WAIT_L
#undef PG8_BAR
#undef PG8_SCHED
}
}

using pg8::Unit;
struct EpiIn {
    static constexpr bool PERM = true;
    bf16_t *QB, *KB, *VB, *UB, *GA, *GP, *SMA, *SMP;
    __device__ __forceinline__ void operator()(const f32x4 (&acc)[2][2][4][2], const Unit& u, int wr, int wc, int fr, int fq) const {
        const int pn = u.pn; int mode, ld = 1024, cb; bf16_t* base; bool bt = false;
        if (pn < 4)       { mode = 0; base = QB; cb = pn * 256; }
        else if (pn < 8)  { mode = 1; base = KB; cb = (pn - 4) * 256; bt = true; }
        else if (pn < 12) { mode = 1; base = VB; cb = (pn - 8) * 256; bt = true; }
        else if (pn < 16) { mode = 2; base = GA; cb = (pn - 12) * 256; }
        else if (pn < 20) { mode = 1; base = UB; cb = (pn - 16) * 256; bt = true; }
        else if (pn < 24) { mode = 2; base = GP; cb = (pn - 20) * 256; }
        else if (pn < 32) { mode = 3; base = SMA; cb = (pn - 24) * 256; ld = 2048; }
        else              { mode = 3; base = SMP; cb = (pn - 32) * 256; ld = 2048; }
        const int col0 = cb + wc * 32 + 8 * fq;
#pragma unroll
        for (int ai = 0; ai < 2; ++ai)
#pragma unroll
            for (int m = 0; m < 4; ++m) {
                const int row = u.pm * 256 + ai * 128 + wr * 64 + m * 16 + fr;
                if (row < MROWS) {
                    const int drow = bt ? btrow(row) : row;
                    bf16_t* rowp = base + (size_t)drow * ld + col0;
#pragma unroll
                    for (int bj = 0; bj < 2; ++bj) {
                        f32x4 v0 = acc[ai][bj][m][0], v1 = acc[ai][bj][m][1];
                        if (mode == 0) { v0 = v0 * QSCALE; v1 = v1 * QSCALE; }
                        else if (mode == 2) {
#pragma unroll
                            for (int e = 0; e < 4; ++e) { v0[e] = v0[e] * fsigmoid(v0[e]); v1[e] = v1[e] * fsigmoid(v1[e]); }
                        } else if (mode == 3) {
#pragma unroll
                            for (int e = 0; e < 4; ++e) { v0[e] = fsigmoid(v0[e]); v1[e] = fsigmoid(v1[e]); }
                        }
                        u32x4 w; w.x = cvt_pk_bf16(v0[0], v0[1]); w.y = cvt_pk_bf16(v0[2], v0[3]); w.z = cvt_pk_bf16(v1[0], v1[1]); w.w = cvt_pk_bf16(v1[2], v1[3]);
                        *(u32x4*)(rowp + bj * 128) = w;
                    }
                }
                asm volatile("" ::: "memory");
            }
    }
};
struct EpiPool {
    static constexpr bool PERM = true;
    const float* scale; const bf16_t* GP; bf16_t* OAP; int g;
    __device__ __forceinline__ void operator()(const f32x4 (&acc)[2][2][4][2], const Unit& u, int wr, int wc, int fr, int fq) const {
        const int col0 = g * 256 + wc * 32 + 8 * fq;
#pragma unroll
        for (int ai = 0; ai < 2; ++ai)
#pragma unroll
            for (int m = 0; m < 4; ++m) {
                const int row = u.pm * 256 + ai * 128 + wr * 64 + m * 16 + fr;
                if (row < MROWS) {
#pragma unroll
                    for (int bj = 0; bj < 2; ++bj) {
                        const f32x4 s0 = *(const f32x4*)(scale + col0 + bj * 128), s1 = *(const f32x4*)(scale + col0 + bj * 128 + 4);
                        const u32x4 gw = *(const u32x4*)(GP + (size_t)row * 1024 + col0 + bj * 128);
                        const f32x4 a0 = acc[ai][bj][m][0], a1 = acc[ai][bj][m][1];
                        u32x4 w;
                        w.x = cvt_pk_bf16(a0[0] * s0[0] * bf_lo(gw.x), a0[1] * s0[1] * bf_hi(gw.x));
                        w.y = cvt_pk_bf16(a0[2] * s0[2] * bf_lo(gw.y), a0[3] * s0[3] * bf_hi(gw.y));
                        w.z = cvt_pk_bf16(a1[0] * s1[0] * bf_lo(gw.z), a1[1] * s1[1] * bf_hi(gw.z));
                        w.w = cvt_pk_bf16(a1[2] * s1[2] * bf_lo(gw.w), a1[3] * s1[3] * bf_hi(gw.w));
                        *(u32x4*)(OAP + (size_t)row * 2048 + 1024 + col0 + bj * 128) = w;
                    }
                }
                asm volatile("" ::: "memory");
            }
    }
};
struct EpiT1 {
    static constexpr bool PERM = true;
    const bf16_t* SMA; float* T1;
    __device__ __forceinline__ void operator()(const f32x4 (&acc)[2][2][4][2], const Unit& u, int wr, int wc, int fr, int fq) const {
        const int col0 = u.pn * 256 + wc * 32 + 8 * fq;
#pragma unroll
        for (int ai = 0; ai < 2; ++ai)
#pragma unroll
            for (int m = 0; m < 4; ++m) {
                const int row = u.pm * 256 + ai * 128 + wr * 64 + m * 16 + fr;
                if (row < MROWS) {
#pragma unroll
                    for (int bj = 0; bj < 2; ++bj) {
                        const size_t off = (size_t)row * 2048 + col0 + bj * 128;
                        const u32x4 gw = *(const u32x4*)(SMA + off);
                        const f32x4 a0 = acc[ai][bj][m][0], a1 = acc[ai][bj][m][1];
                        f32x4 o0, o1;
                        o0[0] = a0[0] * bf_lo(gw.x); o0[1] = a0[1] * bf_hi(gw.x); o0[2] = a0[2] * bf_lo(gw.y); o0[3] = a0[3] * bf_hi(gw.y);
                        o1[0] = a1[0] * bf_lo(gw.z); o1[1] = a1[1] * bf_hi(gw.z); o1[2] = a1[2] * bf_lo(gw.w); o1[3] = a1[3] * bf_hi(gw.w);
                        *(f32x4*)(T1 + off) = o0; *(f32x4*)(T1 + off + 4) = o1;
                    }
                }
                asm volatile("" ::: "memory");
            }
    }
};
struct EpiMg {
    static constexpr bool PERM = true;
    const bf16_t* SMP; const float* T1; bf16_t* MG;
    __device__ __forceinline__ void operator()(const f32x4 (&acc)[2][2][4][2], const Unit& u, int wr, int wc, int fr, int fq) const {
        const int col0 = u.pn * 256 + wc * 32 + 8 * fq;
#pragma unroll
        for (int ai = 0; ai < 2; ++ai)
#pragma unroll
            for (int m = 0; m < 4; ++m) {
                const int row = u.pm * 256 + ai * 128 + wr * 64 + m * 16 + fr;
                if (row < MROWS) {
#pragma unroll
                    for (int bj = 0; bj < 2; ++bj) {
                        const size_t off = (size_t)row * 2048 + col0 + bj * 128;
                        const u32x4 gw = *(const u32x4*)(SMP + off);
                        const f32x4 t0 = *(const f32x4*)(T1 + off), t1 = *(const f32x4*)(T1 + off + 4);
                        const f32x4 a0 = acc[ai][bj][m][0], a1 = acc[ai][bj][m][1];
                        u32x4 w;
                        w.x = cvt_pk_bf16(t0[0] + a0[0] * bf_lo(gw.x), t0[1] + a0[1] * bf_hi(gw.x));
                        w.y = cvt_pk_bf16(t0[2] + a0[2] * bf_lo(gw.y), t0[3] + a0[3] * bf_hi(gw.y));
                        w.z = cvt_pk_bf16(t1[0] + a1[0] * bf_lo(gw.z), t1[1] + a1[1] * bf_hi(gw.z));
                        w.w = cvt_pk_bf16(t1[2] + a1[2] * bf_lo(gw.w), t1[3] + a1[3] * bf_hi(gw.w));
                        *(u32x4*)(MG + off) = w;
                    }
                }
                asm volatile("" ::: "memory");
            }
    }
};
struct EpiRes {
    static constexpr bool PERM = true;
    float* XS;
    __device__ __forceinline__ void operator()(const f32x4 (&acc)[2][2][4][2], const Unit& u, int wr, int wc, int fr, int fq) const {
        const int col0 = u.pn * 256 + wc * 32 + 8 * fq;
#pragma unroll
        for (int ai = 0; ai < 2; ++ai)
#pragma unroll
            for (int m = 0; m < 4; ++m) {
                const int row = u.pm * 256 + ai * 128 + wr * 64 + m * 16 + fr;
                if (row < MROWS) {
#pragma unroll
                    for (int bj = 0; bj < 2; ++bj) {
                        const size_t off = (size_t)row * 2048 + col0 + bj * 128;
                        const f32x4 t0 = *(const f32x4*)(XS + off), t1 = *(const f32x4*)(XS + off + 4);
                        *(f32x4*)(XS + off) = t0 + acc[ai][bj][m][0]; *(f32x4*)(XS + off + 4) = t1 + acc[ai][bj][m][1];
                    }
                }
                asm volatile("" ::: "memory");
            }
    }
};

struct Args {
    const float* x; const float* meta; const float* norm_gain; const float* w_in; const float* pool_w; const float* pool_scale;
    const float* w_attn_up; const float* w_pool_up; const float* w_out; const float* final_gain;
    float* out; unsigned char* ws; int ph_lo, ph_hi;
};

__device__ __forceinline__ void transpose_item(const float* W, int N, bf16_t* WT, int ldwt, int coff, LAS float* scr, int kb, int nb, int lane) {
    const int k0 = 64 * kb, n0 = 32 * nb;
#pragma unroll 8
    for (int i = 0; i < 32; ++i) { const int kk = 2 * i + (lane >> 5); scr[kk * 33 + (lane & 31)] = W[(size_t)(k0 + kk) * N + n0 + (lane & 31)]; }
    asm volatile("s_waitcnt lgkmcnt(0)" ::: "memory");
    const int c = lane & 7;
#pragma unroll
    for (int j = 0; j < 4; ++j) { const int n = (lane >> 3) + 8 * j; const LAS float* s = scr + (8 * c) * 33 + n;
        u32x4 o; o.x = cvt_pk_bf16(s[0 * 33], s[1 * 33]); o.y = cvt_pk_bf16(s[2 * 33], s[3 * 33]); o.z = cvt_pk_bf16(s[4 * 33], s[5 * 33]); o.w = cvt_pk_bf16(s[6 * 33], s[7 * 33]);
        *(u32x4*)(WT + (size_t)(n0 + n) * ldwt + coff + k0 + 8 * c) = o; }
    asm volatile("s_waitcnt lgkmcnt(0)" ::: "memory");
}
__device__ __forceinline__ void rms_row_bf16(const float* xrow, const float* gain, bf16_t* orow, float* xs_out, int lane) {
    const f32x4* xr = (const f32x4*)xrow + lane;
    f32x4 v[8]; float s = 0.f;
#pragma unroll
    for (int j = 0; j < 8; ++j) { v[j] = xr[64 * j]; s += (v[j][0] * v[j][0] + v[j][1] * v[j][1]) + (v[j][2] * v[j][2] + v[j][3] * v[j][3]); }
    const float r = 1.0f / sqrtf(wave_sum(s, lane) * (1.0f / DM) + RMS_EPS);
    if (xs_out) {
#pragma unroll
        for (int j = 0; j < 8; ++j) ((f32x4*)xs_out + lane)[64 * j] = v[j];
    }
    const f32x4* gr = (const f32x4*)gain + lane;
    u32x2* o8 = (u32x2*)orow + lane;
#pragma unroll
    for (int j = 0; j < 8; ++j) { const f32x4 g = gr[64 * j]; u32x2 w; w.x = cvt_pk_bf16(v[j][0] * r * g[0], v[j][1] * r * g[1]); w.y = cvt_pk_bf16(v[j][2] * r * g[2], v[j][3] * r * g[3]); o8[64 * j] = w; }
}
__device__ __forceinline__ void rms_row_f32(const float* xrow, const float* gain, float* orow, int lane) {
    const f32x4* xr = (const f32x4*)xrow + lane;
    f32x4 v[8]; float s = 0.f;
#pragma unroll
    for (int j = 0; j < 8; ++j) { v[j] = xr[64 * j]; s += (v[j][0] * v[j][0] + v[j][1] * v[j][1]) + (v[j][2] * v[j][2] + v[j][3] * v[j][3]); }
    const float r = 1.0f / sqrtf(wave_sum(s, lane) * (1.0f / DM) + RMS_EPS);
    const f32x4* gr = (const f32x4*)gain + lane;
#pragma unroll
    for (int j = 0; j < 8; ++j) { const f32x4 g = gr[64 * j]; ((f32x4*)orow + lane)[64 * j] = v[j] * r * g; }
}

constexpr int KS = 272;
constexpr int TILEB = 64 * KS;
__device__ __forceinline__ float fexp2(float x) { return __builtin_amdgcn_exp2f(x); }
__device__ __forceinline__ float frcp(float x) { return __builtin_amdgcn_rcpf(x); }

__device__ __forceinline__ void attn_unit(LAS unsigned char* lds, const bf16_t* __restrict__ QB, const bf16_t* __restrict__ KB, const bf16_t* __restrict__ VB,
                                          const bf16_t* __restrict__ GA, bf16_t* __restrict__ OAP, int b, int h, int qb) {
    const int tid = tid_fresh(), w = __builtin_amdgcn_readfirstlane(tid >> 6), l = tid & 63, qi = l & 15, lg = l >> 4;
    const int tq0 = 64 + 128 * qb + 16 * w;
    const bool wactive = (tq0 >= TOFF);
    const int tq = tq0 + qi;
    const int mrow = (tq0 >= 64) ? (b * 2048 + tq - 64) : (MREAL + 16 * b + (wactive ? tq - TOFF : 0));
    const int jtop = (qb >= 0) ? 2 * qb + 2 : 0, ntiles = jtop + 1;
    const int jw = wactive ? ((tq0 + 14) >> 6) : -1;
    bf16x8 qf[4];
#pragma unroll
    for (int dc = 0; dc < 4; ++dc) qf[dc] = *(const bf16x8*)(QB + (size_t)mrow * 1024 + h * 128 + dc * 32 + lg * 8);
    f32x4 o[8];
#pragma unroll
    for (int dg = 0; dg < 8; ++dg) o[dg] = (f32x4){0.f, 0.f, 0.f, 0.f};
    float P = 1.0f;
    const size_t gbase = ((size_t)b * LP) * 1024 + h * 128;
    u32x4 kreg[2], vreg[2];
    auto gload = [&](int j) {
#pragma unroll
        for (int i = 0; i < 2; ++i) { const int p = tid + 512 * i, r = p >> 4, c = p & 15; const size_t off = gbase + (size_t)(64 * j + r) * 1024 + c * 8;
            kreg[i] = *(const u32x4*)(KB + off); vreg[i] = *(const u32x4*)(VB + off); }
    };
    auto lwrite = [&](int buf) {
#pragma unroll
        for (int i = 0; i < 2; ++i) { const int p = tid + 512 * i, r = p >> 4, c = p & 15;
            *(LAS u32x4*)(lds + buf * 2 * TILEB + r * KS + c * 16) = kreg[i]; *(LAS u32x4*)(lds + buf * 2 * TILEB + TILEB + r * KS + c * 16) = vreg[i]; }
    };
    gload(jtop); lwrite(0);
    __syncthreads();
    const int kbase = (16 * (qi >> 2) + (qi & 3)) * KS + lg * 16;
    const int vbase = (16 * lg + (qi >> 2)) * KS + (qi & 3) * 8;
    for (int it = 0; it < ntiles; ++it) {
        const int j = jtop - it, cur = it & 1;
        if (it + 1 < ntiles) gload(j - 1);
        if (j <= jw) {
            LAS unsigned char* Kb = lds + cur * 2 * TILEB; LAS unsigned char* Vb = Kb + TILEB;
            f32x4 s[4];
            float zf = 0.f; asm volatile("" : "+v"(zf));
#pragma unroll
            for (int g = 0; g < 4; ++g) s[g] = (f32x4){zf, zf, zf, zf};
#pragma unroll
            for (int dc = 0; dc < 4; ++dc)
#pragma unroll
                for (int g = 0; g < 4; ++g) { const bf16x8 kf = *(const LAS bf16x8*)(Kb + kbase + g * 4 * KS + dc * 64); s[g] = __builtin_amdgcn_mfma_f32_16x16x32_bf16(kf, qf[dc], s[g], 0, 0, 0); }
            const bool need_mask = (64 * j + 63 >= tq0) || (j == 0);
            float beta[16], omb[16];
#pragma unroll
            for (int kk = 0; kk < 16; ++kk) {
                const float z = fmaxf(s[kk >> 2][kk & 3], -60.0f);
                const float t = fexp2(-z), r = frcp(1.0f + t);
                beta[kk] = r; omb[kk] = t * r;
            }
            if (need_mask) {
                const int tk0 = 64 * j + 16 * lg;
#pragma unroll
                for (int kk = 0; kk < 16; ++kk) { const int tk = tk0 + kk; const bool valid = (tk >= TOFF) && (tk < tq); beta[kk] = valid ? beta[kk] : 0.0f; omb[kk] = valid ? omb[kk] : 1.0f; }
            }
            float e[16]; e[15] = 1.0f;
#pragma unroll
            for (int kk = 14; kk >= 0; --kk) e[kk] = e[kk + 1] * omb[kk + 1];
            const float T = e[0] * omb[0];
            const float T1 = shfl_idx(T, (l + 16) & 63), T2 = shfl_idx(T, (l + 32) & 63), T3 = shfl_idx(T, (l + 48) & 63);
            float G = 1.0f;
            if (lg <= 2) G *= T1;
            if (lg <= 1) G *= T2;
            if (lg == 0) G *= T3;
            const float c = P * G;
            P = P * ((T * T1) * (T2 * T3));
            float a[16];
#pragma unroll
            for (int kk = 0; kk < 16; ++kk) a[kk] = beta[kk] * (e[kk] * c);
            bf16x8 pa[2];
#pragma unroll
            for (int mm = 0; mm < 2; ++mm) {
                u32x4 wv; wv.x = cvt_pk_bf16(a[8 * mm + 0], a[8 * mm + 1]); wv.y = cvt_pk_bf16(a[8 * mm + 2], a[8 * mm + 3]); wv.z = cvt_pk_bf16(a[8 * mm + 4], a[8 * mm + 5]); wv.w = cvt_pk_bf16(a[8 * mm + 6], a[8 * mm + 7]);
                pa[mm] = __builtin_bit_cast(bf16x8, wv);
            }
#pragma unroll
            for (int dg = 0; dg < 8; ++dg)
#pragma unroll
                for (int mm = 0; mm < 2; ++mm) {
                    const s16x4 v0 = __builtin_bit_cast(s16x4, __builtin_amdgcn_ds_read_tr16_b64_v4i16((LAS s16x4*)(Vb + vbase + (8 * mm) * KS + dg * 32)));
                    const s16x4 v1 = __builtin_bit_cast(s16x4, __builtin_amdgcn_ds_read_tr16_b64_v4i16((LAS s16x4*)(Vb + vbase + (8 * mm + 4) * KS + dg * 32)));
                    bf16x8 vf; vf[0] = v0[0]; vf[1] = v0[1]; vf[2] = v0[2]; vf[3] = v0[3]; vf[4] = v1[0]; vf[5] = v1[1]; vf[6] = v1[2]; vf[7] = v1[3];
                    o[dg] = __builtin_amdgcn_mfma_f32_16x16x32_bf16(vf, pa[mm], o[dg], 0, 0, 0);
                }
        }
        if (it + 1 < ntiles) lwrite(cur ^ 1);
        __syncthreads();
    }
    if (wactive) {
#pragma unroll
        for (int dg = 0; dg < 8; ++dg) {
            const size_t col = (size_t)h * 128 + 16 * dg + 4 * lg;
            const u32x2 gw = *(const u32x2*)(GA + (size_t)mrow * 1024 + col);
            u32x2 wv; wv.x = cvt_pk_bf16(o[dg][0] * bf_lo(gw.x), o[dg][1] * bf_hi(gw.x)); wv.y = cvt_pk_bf16(o[dg][2] * bf_lo(gw.y), o[dg][3] * bf_hi(gw.y));
            *(u32x2*)(OAP + (size_t)mrow * 2048 + col) = wv;
        }
    }
}

__device__ __forceinline__ void load8f(const bf16_t* p, float (&f)[8]) {
    const u32x4 w = *(const u32x4*)p;
    f[0] = bf_lo(w.x); f[1] = bf_hi(w.x); f[2] = bf_lo(w.y); f[3] = bf_hi(w.y); f[4] = bf_lo(w.z); f[5] = bf_hi(w.z); f[6] = bf_lo(w.w); f[7] = bf_hi(w.w);
}
__device__ __forceinline__ void pool_unit(LAS unsigned char* lds, const bf16_t* __restrict__ UB, bf16_t* __restrict__ PL, const bf16_t* PWT  , const float* scale  ,
                                          const bf16_t* GP, bf16_t* OAP, int pm, int g) {
    const int tid = tid_fresh(), cc = tid & 31, strip = tid >> 5;
    const int w = 2 << g;
    int b, tb, m0; bool valid = true;
    if (pm < 32) { const int r0 = pm * 256 + strip * 16; b = r0 >> 11; tb = 64 + (r0 & 2047); m0 = r0; }
    else { b = strip & 3; tb = TOFF; m0 = MREAL + 16 * (strip & 3); valid = strip < 4; }
    if (valid) {
        const bf16_t* up = UB + ((size_t)(b * LP + tb)) * 1024 + g * 256 + cc * 8;
        float S[8];
#pragma unroll
        for (int e = 0; e < 8; ++e) S[e] = 0.f;
        for (int j = 1; j < w; ++j) { float f[8]; load8f(up - (size_t)j * 1024, f);
#pragma unroll
            for (int e = 0; e < 8; ++e) S[e] += f[e]; }
        for (int rr = 0; rr < 16; ++rr) {
            float cu[8]; load8f(up + (size_t)rr * 1024, cu);
            if (rr > 0) { float f[8]; load8f(up + (size_t)(rr - w) * 1024, f);
#pragma unroll
                for (int e = 0; e < 8; ++e) S[e] -= f[e]; }
#pragma unroll
            for (int e = 0; e < 8; ++e) S[e] += cu[e];
            const int t = tb + rr - TOFF; const float inv = 1.0f / (float)((t + 1) < w ? (t + 1) : w);
            u32x4 o; o.x = cvt_pk_bf16(S[0] * inv - cu[0], S[1] * inv - cu[1]); o.y = cvt_pk_bf16(S[2] * inv - cu[2], S[3] * inv - cu[3]);
            o.z = cvt_pk_bf16(S[4] * inv - cu[4], S[5] * inv - cu[5]); o.w = cvt_pk_bf16(S[6] * inv - cu[6], S[7] * inv - cu[7]);
            *(u32x4*)(PL + (size_t)(m0 + rr) * 1024 + g * 256 + cc * 8) = o;
        }
    }
    __threadfence();
    __syncthreads();
    pg8::Gemm gm{PL + g * 256, PWT + (size_t)g * GD * GD, 1024, 256, 256};
    pg8::OneUnit S1{{pm, 0}};
    EpiPool E{scale, GP, OAP, g};
    pg8::gemm_phase<EpiPool, pg8::OneUnit, true, true>(lds, gm, S1, E);
}

constexpr int PH_PRO = 0, PH_FINAL = 1 + 5 * DEPTH, N_PHASES = PH_FINAL + 1;
constexpr int N_ATT = 32 * 16, N_POOLU = 33 * 4, N_METAU = 32, N_BITEMS = N_ATT + N_POOLU + N_METAU;

#define TID_VARS() const int tid = tid_fresh(), lane = tid & 63, wave = __builtin_amdgcn_readfirstlane(tid >> 6); const int gw = bx * 8 + wave, NGW = G * 8; (void)lane; (void)gw; (void)NGW; (void)tid;
#define WS_PTRS() \
    unsigned char* ws = args.ws; asm volatile("" : "+s"(ws)); \
    unsigned* ctl = (unsigned*)(ws + WS_CTL); (void)ctl; \
    float* XS = (float*)(ws + WS_XS); bf16_t* HB = (bf16_t*)(ws + WS_HB); (void)XS; (void)HB; \
    bf16_t* WIN = (bf16_t*)(ws + WS_WIN); bf16_t* WM = (bf16_t*)(ws + WS_WM); bf16_t* WO = (bf16_t*)(ws + WS_WO); bf16_t* PWT = (bf16_t*)(ws + WS_PW); (void)WIN; (void)WM; (void)WO; (void)PWT; \
    bf16_t* QB = (bf16_t*)(ws + WS_QB); bf16_t* KB = (bf16_t*)(ws + WS_KB); bf16_t* VB = (bf16_t*)(ws + WS_VB); bf16_t* UB = (bf16_t*)(ws + WS_UB); (void)QB; (void)KB; (void)VB; (void)UB; \
    bf16_t* GA = (bf16_t*)(ws + WS_GA); bf16_t* GP = (bf16_t*)(ws + WS_GP); bf16_t* SMA = (bf16_t*)(ws + WS_SMA); bf16_t* SMP = (bf16_t*)(ws + WS_SMP); (void)GA; (void)GP; (void)SMA; (void)SMP; \
    bf16_t* OAP = (bf16_t*)(ws + WS_OAP); bf16_t* PL = (bf16_t*)(ws + WS_PL); float* T1 = (float*)(ws + WS_T1); bf16_t* MG = (bf16_t*)(ws + WS_MG); (void)OAP; (void)PL; (void)T1; (void)MG;
__global__ void __launch_bounds__(512, 2) mega_fwd(Args args) {
    extern __shared__ __attribute__((aligned(16))) unsigned char lds_raw[];
    LAS unsigned char* lds = (LAS unsigned char*)lds_raw;
    cg::grid_group grid = cg::this_grid();
    const int G = gridDim.x, bx = blockIdx.x;
    for (int ph = args.ph_lo; ph < args.ph_hi; ++ph) {
        if (ph == PH_PRO) {
            WS_PTRS(); TID_VARS();

#ifndef DIS_PRO
            LAS float* scr = (LAS float*)(lds + wave * 8704);
            constexpr int I_IN = 32 * 320, I_UP = 16 * 64, I_OUT = 32 * 64, I_PW = 4 * 8;
            constexpr int PER_L = I_IN + 2 * I_UP + I_OUT + 4 * I_PW;
            for (int it = gw; it < DEPTH * PER_L; it += NGW) {
                const int L = it / PER_L; int r = it % PER_L;
                if (r < I_IN) { transpose_item(args.w_in + (size_t)L * DM * INC, INC, WIN + (size_t)L * INC * DM, DM, 0, scr, r / 320, r % 320, lane); continue; } r -= I_IN;
                if (r < I_UP) { transpose_item(args.w_attn_up + (size_t)L * SBW * DM, DM, WM + (size_t)L * DM * DM, DM, 0, scr, r / 64, r % 64, lane); continue; } r -= I_UP;
                if (r < I_UP) { transpose_item(args.w_pool_up + (size_t)L * PWD * DM, DM, WM + (size_t)L * DM * DM, DM, 1024, scr, r / 64, r % 64, lane); continue; } r -= I_UP;
                if (r < I_OUT) { transpose_item(args.w_out + (size_t)L * DM * DM, DM, WO + (size_t)L * DM * DM, DM, 0, scr, r / 64, r % 64, lane); continue; } r -= I_OUT;
                { const int gq = r / I_PW, rr = r % I_PW; transpose_item(args.pool_w + ((size_t)L * 4 + gq) * GD * GD, GD, PWT + ((size_t)L * 4 + gq) * GD * GD, GD, 0, scr, rr / 8, rr % 8, lane); }
            }
            for (int m = gw; m < MROWS; m += NGW) {
                const float* src = (m < MREAL) ? args.x + (size_t)m * DM : args.meta + (size_t)((m - MREAL) & 15) * DM;
                rms_row_bf16(src, args.norm_gain, HB + (size_t)m * DM, XS + (size_t)m * DM, lane);
            }
            { unsigned zu = 0u; asm volatile("" : "+v"(zu)); const int gt = bx * 512 + tid, NGT = G * 512; constexpr int PIECES = NB * TOFF * 128;
              for (int p = gt; p < 3 * PIECES; p += NGT) { const int bufi = p / PIECES, q = p % PIECES, bb = q / (TOFF * 128), rem = q % (TOFF * 128);
                  bf16_t* base = bufi == 0 ? KB : (bufi == 1 ? VB : UB);
                  *(u32x4*)(base + (size_t)bb * LP * 1024 + (size_t)rem * 8) = (u32x4){zu, zu, zu, zu}; } }
            if (bx == 0 && tid < 64) ctl[tid] = 0u;
#endif

        } else if (ph == PH_FINAL) {
            WS_PTRS(); TID_VARS();
            for (int m = gw; m < MREAL; m += NGW) rms_row_f32(XS + (size_t)m * DM, args.final_gain, args.out + (size_t)m * DM, lane);
        } else {
            const int L = (ph - 1) / 5, sub = (ph - 1) % 5;
            if (sub == 0) {
                WS_PTRS(); TID_VARS();
                if (L > 0) for (int m = gw; m < MROWS; m += NGW) rms_row_bf16(XS + (size_t)m * DM, args.norm_gain + (size_t)L * DM, HB + (size_t)m * DM, nullptr, lane);
            } else if (sub == 1) {
                WS_PTRS();

#ifndef DIS_A
                pg8::Gemm g{HB, WIN + (size_t)L * INC * DM, DM, DM, DM}; pg8::StaticOrder S; S.init(MPAD, INC, G, bx);
                EpiIn E{QB, KB, VB, UB, GA, GP, SMA, SMP};
                pg8::gemm_phase<EpiIn, pg8::StaticOrder, true, true>(lds, g, S, E);
#endif

            } else if (sub == 2) {
                WS_PTRS();
                LAS volatile int* item_s = (LAS volatile int*)(lds + MISC_OFF);
                for (;;) {
                    __syncthreads();
                    if (tid_fresh() == 0) *item_s = (int)atomicAdd(ctl + L, 1u);
                    __syncthreads();
                    const int item = *item_s;
                    if (item >= N_BITEMS) break;

#ifndef DIS_B
                    if (item < N_ATT || item >= N_ATT + N_POOLU) {
#ifndef DIS_ATT
                        const int qb = item < N_ATT ? 15 - item / 32 : -1, bh = item < N_ATT ? item % 32 : item - N_ATT - N_POOLU;
                        attn_unit(lds, QB, KB, VB, GA, OAP, bh >> 3, bh & 7, qb);
#endif
                    } else {
#ifndef DIS_POOL
                        const int r = item - N_ATT; pool_unit(lds, UB, PL, PWT + (size_t)L * 4 * GD * GD, args.pool_scale + (size_t)L * PWD, GP, OAP, r >> 2, r & 3);
#endif
                    }
#endif

                }
            } else if (sub == 3) {
                WS_PTRS();
                pg8::StaticOrder S; S.init(MPAD, DM, G, bx);

#ifndef DIS_C
                { pg8::Gemm g{OAP, WM + (size_t)L * DM * DM, DM, DM, 1024}; EpiT1 E{SMA, T1}; pg8::gemm_phase<EpiT1, pg8::StaticOrder, true, true>(lds, g, S, E); }
                { pg8::Gemm g{OAP + 1024, WM + (size_t)L * DM * DM + 1024, DM, DM, 1024}; EpiMg E{SMP, T1, MG}; pg8::gemm_phase<EpiMg, pg8::StaticOrder, true, true>(lds, g, S, E); }
#endif

            } else {
                WS_PTRS();
#ifndef DIS_D
                pg8::Gemm g{MG, WO + (size_t)L * DM * DM, DM, DM, DM}; pg8::StaticOrder S; S.init(MPAD, DM, G, bx);
                EpiRes E{XS};
                pg8::gemm_phase<EpiRes, pg8::StaticOrder, true, true>(lds, g, S, E);
#endif

            }
        }
        if (ph + 1 < args.ph_hi) grid.sync();
    }
}

extern "C" void kernel_launch(void* const* d_in, const int* in_sizes, int n_in, void* d_out, int out_size, void* d_ws, size_t ws_size, hipStream_t stream) {
    static int grid = 0;
    if (grid == 0) {
        if (n_in != 10 || ws_size < WS_END) { fprintf(stderr, "kernel_launch: need 10 inputs and >= %zu bytes of workspace (got %d, %zu)\n", (size_t)WS_END, n_in, ws_size); grid = -1; return; }
        int dev = 0, cus = 0, per_cu = 0;
        hipGetDevice(&dev); hipDeviceGetAttribute(&cus, hipDeviceAttributeMultiprocessorCount, dev);
        if (hipFuncSetAttribute((const void*)mega_fwd, hipFuncAttributeMaxDynamicSharedMemorySize, LDS_BYTES) != hipSuccess) { fprintf(stderr, "kernel_launch: hipFuncSetAttribute failed\n"); grid = -1; return; }
        if (hipOccupancyMaxActiveBlocksPerMultiprocessor(&per_cu, (const void*)mega_fwd, 512, LDS_BYTES) != hipSuccess || per_cu < 1) { fprintf(stderr, "kernel_launch: occupancy query gave %d\n", per_cu); per_cu = 1; }
        (void)hipGetLastError();
        grid = cus * per_cu;
    }
    if (grid < 0) return;
    Args a{};
    a.x = (const float*)d_in[0]; a.meta = (const float*)d_in[1]; a.norm_gain = (const float*)d_in[2]; a.w_in = (const float*)d_in[3]; a.pool_w = (const float*)d_in[4];
    a.pool_scale = (const float*)d_in[5]; a.w_attn_up = (const float*)d_in[6]; a.w_pool_up = (const float*)d_in[7]; a.w_out = (const float*)d_in[8]; a.final_gain = (const float*)d_in[9];
    a.out = (float*)d_out; a.ws = (unsigned char*)d_ws;
#if MK_MULTI
    for (int ph = 0; ph < N_PHASES; ++ph) {
        if (ph >= 1 && ph < PH_FINAL && (ph - 1) % 5 == 0 && (ph - 1) / 5 == 0) continue;
        a.ph_lo = ph; a.ph_hi = ph + 1;
        hipLaunchKernelGGL(mega_fwd, dim3(grid), dim3(512), LDS_BYTES, stream, a);
    }
#else
    a.ph_lo = 0; a.ph_hi = N_PHASES;
    void* kargs[] = {&a};
    hipError_t e = hipLaunchCooperativeKernel((const void*)mega_fwd, dim3(grid), dim3(512), kargs, LDS_BYTES, stream);
    if (e != hipSuccess) fprintf(stderr, "cooperative launch failed: %s (grid %d)\n", hipGetErrorString(e), grid);
#endif
}
```

```cpp
#include <hip/hip_runtime.h>
#include <hip/hip_cooperative_groups.h>
#include <cstdio>
#include <cstdint>
namespace cg = cooperative_groups;

#ifndef MK_MULTI
#define MK_MULTI 0
#endif

#define LAS __attribute__((address_space(3)))
typedef unsigned short bf16_t;
typedef short bf16x8 __attribute__((ext_vector_type(8)));
typedef short s16x4 __attribute__((ext_vector_type(4)));
typedef float f32x4 __attribute__((ext_vector_type(4)));
typedef unsigned u32x4 __attribute__((ext_vector_type(4)));
typedef unsigned u32x2 __attribute__((ext_vector_type(2)));

constexpr int DM = 2048, NB = 4, SEQ = 2048, DEPTH = 4, NMETA = 16, NH = 8, DH = 128, SBW = 1024, PWD = 1024, GD = 256, INC = 10240;
constexpr int MREAL = NB * SEQ;
constexpr int MROWS = MREAL + NB * NMETA;
constexpr int MPAD = 8448;
constexpr int LP = 2176;
constexpr int TOFF = 48;
constexpr float RMS_EPS = 1e-6f;
constexpr float LOG2E = 1.4426950408889634f;
constexpr float QSCALE = 0.08838834764831845f * LOG2E;

constexpr size_t al256(size_t x) { return (x + 255) & ~(size_t)255; }
constexpr size_t WS_CTL = 0;
constexpr size_t WS_XS = 4096;
constexpr size_t WS_HB = al256(WS_XS + (size_t)MPAD * DM * 4);
constexpr size_t WS_WIN = al256(WS_HB + (size_t)MPAD * DM * 2);
constexpr size_t WS_WM = al256(WS_WIN + (size_t)DEPTH * INC * DM * 2);
constexpr size_t WS_WO = al256(WS_WM + (size_t)DEPTH * DM * DM * 2);
constexpr size_t WS_PW = al256(WS_WO + (size_t)DEPTH * DM * DM * 2);
constexpr size_t WS_QB = al256(WS_PW + (size_t)DEPTH * 4 * GD * GD * 2);
constexpr size_t WS_KB = al256(WS_QB + (size_t)MPAD * 1024 * 2);
constexpr size_t WS_VB = al256(WS_KB + (size_t)NB * LP * 1024 * 2);
constexpr size_t WS_UB = al256(WS_VB + (size_t)NB * LP * 1024 * 2);
constexpr size_t WS_GA = al256(WS_UB + (size_t)NB * LP * 1024 * 2);
constexpr size_t WS_GP = al256(WS_GA + (size_t)MPAD * 1024 * 2);
constexpr size_t WS_SMA = al256(WS_GP + (size_t)MPAD * 1024 * 2);
constexpr size_t WS_SMP = al256(WS_SMA + (size_t)MPAD * DM * 2);
constexpr size_t WS_OAP = al256(WS_SMP + (size_t)MPAD * DM * 2);
constexpr size_t WS_PL = al256(WS_OAP + (size_t)MPAD * DM * 2);
constexpr size_t WS_T1 = al256(WS_PL + (size_t)MPAD * 1024 * 2);
constexpr size_t WS_MG = al256(WS_T1 + (size_t)MPAD * DM * 4);
constexpr size_t WS_END = al256(WS_MG + (size_t)MPAD * DM * 2);

constexpr int LDS_BYTES = 147456;
constexpr int RING_BYTES = 131072;
constexpr int MISC_OFF = RING_BYTES;

__device__ __forceinline__ unsigned cvt_pk_bf16(float lo, float hi) { unsigned r; asm volatile("v_cvt_pk_bf16_f32 %0, %1, %2" : "=v"(r) : "v"(lo), "v"(hi)); return r; }
__device__ __forceinline__ int tid_fresh() { int t = threadIdx.x; asm volatile("" : "+v"(t)); return t; }
__device__ __forceinline__ float bf_lo(unsigned w) { return __uint_as_float(w << 16); }
__device__ __forceinline__ float bf_hi(unsigned w) { return __uint_as_float(w & 0xffff0000u); }
__device__ __forceinline__ float fsigmoid(float v) { return __builtin_amdgcn_rcpf(1.0f + __builtin_amdgcn_exp2f(-v * LOG2E)); }
__device__ __forceinline__ float shfl_idx(float v, int srclane) { return __int_as_float(__builtin_amdgcn_ds_bpermute(srclane << 2, __float_as_int(v))); }
__device__ __forceinline__ float wave_sum(float v, int lane) {
#pragma unroll
    for (int o = 1; o < 64; o <<= 1) v += shfl_idx(v, lane ^ o);
    return v;
}
__device__ __forceinline__ int btrow(int row) {
    return row < MREAL ? (row >> 11) * LP + 64 + (row & 2047) : ((row - MREAL) >> 4) * LP + TOFF + ((row - MREAL) & 15);
}

namespace pg8 {
constexpr int BM = 256, BK = 64, HALF = 128, HTB = HALF * BK * 2, STAGE_BYTES = 8 * HTB, NXCD = 8, WGM = 8;
__host__ __device__ __forceinline__ int lds_byte(int r, int c) { const int st = (r >> 4) * 2 + (c >> 5), rr = r & 15, cc = c & 31, ob = rr * 64 + cc * 2; return st * 1024 + (ob ^ (((ob >> 9) & 1) << 5)); }
__host__ __device__ __forceinline__ void stage_rc(int b, int& R, int& C) { const int st = b / 1024, sb = b % 1024, swz = sb ^ (((sb >> 9) & 1) << 5); R = (st >> 1) * 16 + swz / 64; C = (st & 1) * 32 + (swz % 64) / 2; }
__host__ __device__ __forceinline__ int perm32(int rho) { const int n = rho >> 4, i = rho & 15; return 8 * (i >> 2) + 4 * n + (i & 3); }

struct Unit { int pm, pn; };
struct Gemm { const bf16_t* A; const bf16_t* Bt; int lda, ldb, K; };

struct StaticOrder {
    int nM, nN, nwg, G, c;
    __host__ __device__ void init(int M, int N, int G_, int c_) { nM = M / BM; nN = N / BM; nwg = nM * nN; G = G_; c = c_; }
    __host__ __device__ bool next(int i, Unit& u) const {
        const long L = (long)i * G + c; if (L >= nwg) return false;
        int wgid = (int)L; { const int q = nwg / NXCD, r = nwg % NXCD, xcd = wgid % NXCD, off = wgid / NXCD; wgid = (xcd < r ? xcd * (q + 1) : r * (q + 1) + (xcd - r) * q) + off; }
        const int nig = WGM * nN, gid = wgid / nig, fm = gid * WGM, gsz = (nM - fm) < WGM ? (nM - fm) : WGM;
        u.pm = fm + ((wgid % nig) % gsz); u.pn = (wgid % nig) / gsz; return true;
    }
};
struct OneUnit {
    Unit u;
    __device__ bool next(int i, Unit& o) const { if (i) return false; o = u; return true; }
};

template <class Epi, class Sched, bool ALIGN_EPI = true, bool SP2 = true>
__device__ __forceinline__ void gemm_phase(LAS unsigned char* lds, const Gemm g, const Sched& S, const Epi& E) {
    const int tid = tid_fresh(), wid = __builtin_amdgcn_readfirstlane(tid >> 6), lane = tid & 63, wr = wid >> 2, wc = wid & 3, fr = lane & 15, fq = lane >> 4;
    const int K = g.K, nt = K / BK;
    unsigned voffA[2], voffB[2];
#pragma unroll
    for (int i = 0; i < 2; ++i) { int R, C; stage_rc(tid * 16 + i * 8192, R, C); const int Rb = Epi::PERM ? ((R & ~31) + perm32(R & 31)) : R;
        voffA[i] = (unsigned)(R * g.lda + C) * 2u; voffB[i] = (unsigned)(Rb * g.ldb + C) * 2u; }
    const size_t kstep = (size_t)(BK * 2);
    const size_t hstepA = (size_t)HALF * g.lda * 2, hstepB = (size_t)HALF * g.ldb * 2;
    const size_t tstepA = 2 * hstepA, tstepB = 2 * hstepB;
    const unsigned ldsw = (unsigned)wid * 1024u;
    const int aoff = lds_byte(wr * 64 + fr, fq * 8), boff = lds_byte(wc * 32 + fr, fq * 8);
#define PG8_SA(b, h) (((b) * 2 + (h)) * HTB)
#define PG8_SB(b, h) ((4 + (b) * 2 + (h)) * HTB)
#define PG8_STAGE(bufoff, gbase, voff) do { _Pragma("unroll") for (int _i = 0; _i < 2; ++_i) \
        __builtin_amdgcn_global_load_lds((const unsigned*)((const char*)(gbase) + (voff)[_i]), (LAS unsigned*)(lds + (bufoff) + ldsw + _i * 8192), 16, 0, 0); } while (0)
#define PG8_LDA(dst, b, h) do { _Pragma("unroll") for (int m = 0; m < 4; ++m) _Pragma("unroll") for (int k = 0; k < 2; ++k) dst[m][k] = *(const LAS bf16x8*)(lds + PG8_SA(b, h) + aoff + m * 2048 + k * 1024); } while (0)
#define PG8_LDB(dst, b, h) do { _Pragma("unroll") for (int n = 0; n < 2; ++n) _Pragma("unroll") for (int k = 0; k < 2; ++k) dst[n][k] = *(const LAS bf16x8*)(lds + PG8_SB(b, h) + boff + n * 2048 + k * 1024); } while (0)
#define PG8_MMA(ai, bj, At, Bt) do { __builtin_amdgcn_s_setprio(1); _Pragma("unroll") for (int m = 0; m < 4; ++m) _Pragma("unroll") for (int n = 0; n < 2; ++n) _Pragma("unroll") for (int k = 0; k < 2; ++k) \
        acc[ai][bj][m][n] = __builtin_amdgcn_mfma_f32_16x16x32_bf16(Bt[n][k], At[m][k], acc[ai][bj][m][n], 0, 0, 0); __builtin_amdgcn_s_setprio(0); } while (0)
#define PG8_WAIT_V(n) asm volatile("s_waitcnt vmcnt(" #n ")" ::: "memory")
#define PG8_WAIT_L(n) asm volatile("s_waitcnt lgkmcnt(" #n ")" ::: "memory")
#define PG8_BAR __builtin_amdgcn_s_barrier()
#define PG8_SCHED __builtin_amdgcn_sched_barrier(0)
    Unit cur, nxt; int ui = 0;
    if (!S.next(0, cur)) return;
    f32x4 acc[2][2][4][2];
#pragma unroll
    for (int a = 0; a < 2; ++a)
#pragma unroll
        for (int b = 0; b < 2; ++b)
#pragma unroll
            for (int m = 0; m < 4; ++m)
#pragma unroll
                for (int n = 0; n < 2; ++n) acc[a][b][m][n] = (f32x4){0.f, 0.f, 0.f, 0.f};
    bf16x8 At[4][2], B0[2][2], B1[2][2];
    const char* cA = (const char*)g.A + (size_t)cur.pm * tstepA; const char* cB = (const char*)g.Bt + (size_t)cur.pn * tstepB;
    if constexpr (SP2) {
        PG8_STAGE(PG8_SB(0, 0), cB, voffB); PG8_STAGE(PG8_SB(0, 1), cB + hstepB, voffB); PG8_STAGE(PG8_SA(0, 0), cA, voffA); PG8_STAGE(PG8_SA(0, 1), cA + hstepA, voffA);
        if (wr == 1) PG8_BAR;
        PG8_WAIT_V(2); PG8_BAR;
        PG8_STAGE(PG8_SB(1, 0), cB + kstep, voffB); PG8_STAGE(PG8_SA(1, 0), cA + kstep, voffA); PG8_STAGE(PG8_SB(1, 1), cB + hstepB + kstep, voffB);
        PG8_WAIT_V(6); PG8_BAR;
    } else {
        PG8_STAGE(PG8_SB(0, 0), cB, voffB); PG8_STAGE(PG8_SA(0, 0), cA, voffA); PG8_STAGE(PG8_SB(0, 1), cB + hstepB, voffB); PG8_STAGE(PG8_SA(0, 1), cA + hstepA, voffA);
        if (wr == 1) PG8_BAR;
        PG8_WAIT_V(4); PG8_BAR;
        PG8_STAGE(PG8_SB(1, 0), cB + kstep, voffB); PG8_STAGE(PG8_SA(1, 0), cA + kstep, voffA); PG8_STAGE(PG8_SB(1, 1), cB + hstepB + kstep, voffB);
        PG8_WAIT_V(6); PG8_BAR;
    }
    for (;;) {
        const bool has_next = S.next(ui + 1, nxt);
        const char* nA = has_next ? (const char*)g.A + (size_t)nxt.pm * tstepA : cA; const char* nB = has_next ? (const char*)g.Bt + (size_t)nxt.pn * tstepB : cB;
        for (int t = 0; t < nt; t += 2) {
            const bool last = (t == nt - 2);
            const char* a1 = cA + (size_t)(t + 1) * kstep;
            const char* a2 = last ? nA : cA + (size_t)(t + 2) * kstep; const char* b2 = last ? nB : cB + (size_t)(t + 2) * kstep;
            const char* a3 = a2 + kstep; const char* b3 = b2 + kstep;
            if constexpr (SP2) {
            PG8_LDB(B0, 0, 0); PG8_LDB(B1, 0, 1); PG8_SCHED; PG8_LDA(At, 0, 0); PG8_STAGE(PG8_SA(1, 1), a1 + hstepA, voffA);
            PG8_WAIT_V(8); PG8_WAIT_L(0); PG8_BAR; PG8_MMA(0, 0, At, B0); PG8_MMA(0, 1, At, B1); PG8_BAR; PG8_SCHED;
            PG8_LDA(At, 0, 1); PG8_STAGE(PG8_SB(0, 0), b2, voffB); PG8_STAGE(PG8_SB(0, 1), b2 + hstepB, voffB); PG8_STAGE(PG8_SA(0, 0), a2, voffA);
            PG8_WAIT_V(8); PG8_WAIT_L(0); PG8_BAR; PG8_MMA(1, 0, At, B0); PG8_MMA(1, 1, At, B1); PG8_BAR; PG8_SCHED;
            PG8_LDB(B0, 1, 0); PG8_LDB(B1, 1, 1); PG8_SCHED; PG8_LDA(At, 1, 0); PG8_STAGE(PG8_SA(0, 1), a2 + hstepA, voffA);
            PG8_WAIT_V(8); PG8_WAIT_L(0); PG8_BAR; PG8_MMA(0, 0, At, B0); PG8_MMA(0, 1, At, B1); PG8_BAR; PG8_SCHED;
            PG8_LDA(At, 1, 1); PG8_STAGE(PG8_SB(1, 0), b3, voffB); PG8_STAGE(PG8_SB(1, 1), b3 + hstepB, voffB); PG8_STAGE(PG8_SA(1, 0), a3, voffA);
            PG8_WAIT_V(8); PG8_WAIT_L(0); PG8_BAR; PG8_MMA(1, 0, At, B0); PG8_MMA(1, 1, At, B1); PG8_BAR; PG8_SCHED;
            } else {
            PG8_LDB(B0, 0, 0); PG8_SCHED; PG8_LDA(At, 0, 0); PG8_STAGE(PG8_SA(1, 1), a1 + hstepA, voffA);
            PG8_WAIT_L(8); PG8_BAR; PG8_WAIT_L(0); PG8_MMA(0, 0, At, B0); PG8_BAR; PG8_SCHED;
            PG8_LDB(B1, 0, 1); PG8_STAGE(PG8_SB(0, 0), b2, voffB);
            PG8_BAR; PG8_WAIT_L(0); PG8_MMA(0, 1, At, B1); PG8_BAR;
            PG8_LDA(At, 0, 1); PG8_STAGE(PG8_SA(0, 0), a2, voffA);
            PG8_BAR; PG8_WAIT_L(0); PG8_MMA(1, 0, At, B0); PG8_BAR; PG8_SCHED;
            PG8_STAGE(PG8_SB(0, 1), b2 + hstepB, voffB);
            PG8_WAIT_V(6); PG8_BAR; PG8_MMA(1, 1, At, B1); PG8_BAR;
            PG8_LDB(B0, 1, 0); PG8_SCHED; PG8_LDA(At, 1, 0); PG8_STAGE(PG8_SA(0, 1), a2 + hstepA, voffA);
            PG8_WAIT_L(8); PG8_BAR; PG8_WAIT_L(0); PG8_MMA(0, 0, At, B0); PG8_BAR; PG8_SCHED;
            PG8_LDB(B1, 1, 1); PG8_STAGE(PG8_SB(1, 0), b3, voffB);
            PG8_BAR; PG8_WAIT_L(0); PG8_MMA(0, 1, At, B1); PG8_BAR;
            PG8_LDA(At, 1, 1); PG8_STAGE(PG8_SA(1, 0), a3, voffA);
            PG8_BAR; PG8_WAIT_L(0); PG8_MMA(1, 0, At, B0); PG8_BAR; PG8_SCHED;
            PG8_STAGE(PG8_SB(1, 1), b3 + hstepB, voffB);
            PG8_WAIT_V(6); PG8_BAR; PG8_MMA(1, 1, At, B1); PG8_BAR;
            }
        }
        if constexpr (ALIGN_EPI) { if (wr == 0) PG8_BAR; }
        E(acc, cur, wr, wc, fr, fq);
        if (!has_next) break;
#pragma unroll
        for (int a = 0; a < 2; ++a)
#pragma unroll
            for (int b = 0; b < 2; ++b)
#pragma unroll
                for (int m = 0; m < 4; ++m)
#pragma unroll
                    for (int n = 0; n < 2; ++n) acc[a][b][m][n] = (f32x4){0.f, 0.f, 0.f, 0.f};
        cur = nxt; cA = nA; cB = nB; ++ui;
        if constexpr (ALIGN_EPI) { if (wr == 1) PG8_BAR; }
    }
    PG8_WAIT_V(0);
    if constexpr (!ALIGN_EPI) { if (wr == 0) PG8_BAR; }
    PG8_BAR;
#undef PG8_SA
#undef PG8_SB
#undef PG8_STAGE
#undef PG8_LDA
#undef PG8_LDB
#undef PG8_MMA
#undef PG8_WAIT_V
#undef PG8_WAIT_L
#undef PG8_BAR
#undef PG8_SCHED
}
}

using pg8::Unit;
struct EpiIn {
    static constexpr bool PERM = true;
    bf16_t *QB, *KB, *VB, *UB, *GA, *GP, *SMA, *SMP;
    __device__ __forceinline__ void operator()(const f32x4 (&acc)[2][2][4][2], const Unit& u, int wr, int wc, int fr, int fq) const {
        const int pn = u.pn; int mode, ld = 1024, cb; bf16_t* base; bool bt = false;
        if (pn < 4)       { mode = 0; base = QB; cb = pn * 256; }
        else if (pn < 8)  { mode = 1; base = KB; cb = (pn - 4) * 256; bt = true; }
        else if (pn < 12) { mode = 1; base = VB; cb = (pn - 8) * 256; bt = true; }
        else if (pn < 16) { mode = 2; base = GA; cb = (pn - 12) * 256; }
        else if (pn < 20) { mode = 1; base = UB; cb = (pn - 16) * 256; bt = true; }
        else if (pn < 24) { mode = 2; base = GP; cb = (pn - 20) * 256; }
        else if (pn < 32) { mode = 3; base = SMA; cb = (pn - 24) * 256; ld = 2048; }
        else              { mode = 3; base = SMP; cb = (pn - 32) * 256; ld = 2048; }
        const int col0 = cb + wc * 32 + 8 * fq;
#pragma unroll
        for (int ai = 0; ai < 2; ++ai)
#pragma unroll
            for (int m = 0; m < 4; ++m) {
                const int row = u.pm * 256 + ai * 128 + wr * 64 + m * 16 + fr;
                if (row < MROWS) {
                    const int drow = bt ? btrow(row) : row;
                    bf16_t* rowp = base + (size_t)drow * ld + col0;
#pragma unroll
                    for (int bj = 0; bj < 2; ++bj) {
                        f32x4 v0 = acc[ai][bj][m][0], v1 = acc[ai][bj][m][1];
                        if (mode == 0) { v0 = v0 * QSCALE; v1 = v1 * QSCALE; }
                        else if (mode == 2) {
#pragma unroll
                            for (int e = 0; e < 4; ++e) { v0[e] = v0[e] * fsigmoid(v0[e]); v1[e] = v1[e] * fsigmoid(v1[e]); }
                        } else if (mode == 3) {
#pragma unroll
                            for (int e = 0; e < 4; ++e) { v0[e] = fsigmoid(v0[e]); v1[e] = fsigmoid(v1[e]); }
                        }
                        u32x4 w; w.x = cvt_pk_bf16(v0[0], v0[1]); w.y = cvt_pk_bf16(v0[2], v0[3]); w.z = cvt_pk_bf16(v1[0], v1[1]); w.w = cvt_pk_bf16(v1[2], v1[3]);
                        *(u32x4*)(rowp + bj * 128) = w;
                    }
                }
                asm volatile("" ::: "memory");
            }
    }
};
struct EpiPool {
    static constexpr bool PERM = true;
    const float* scale; const bf16_t* GP; bf16_t* OAP; int g;
    __device__ __forceinline__ void operator()(const f32x4 (&acc)[2][2][4][2], const Unit& u, int wr, int wc, int fr, int fq) const {
        const int col0 = g * 256 + wc * 32 + 8 * fq;
#pragma unroll
        for (int ai = 0; ai < 2; ++ai)
#pragma unroll
            for (int m = 0; m < 4; ++m) {
                const int row = u.pm * 256 + ai * 128 + wr * 64 + m * 16 + fr;
                if (row < MROWS) {
#pragma unroll
                    for (int bj = 0; bj < 2; ++bj) {
                        const f32x4 s0 = *(const f32x4*)(scale + col0 + bj * 128), s1 = *(const f32x4*)(scale + col0 + bj * 128 + 4);
                        const u32x4 gw = *(const u32x4*)(GP + (size_t)row * 1024 + col0 + bj * 128);
                        const f32x4 a0 = acc[ai][bj][m][0], a1 = acc[ai][bj][m][1];
                        u32x4 w;
                        w.x = cvt_pk_bf16(a0[0] * s0[0] * bf_lo(gw.x), a0[1] * s0[1] * bf_hi(gw.x));
                        w.y = cvt_pk_bf16(a0[2] * s0[2] * bf_lo(gw.y), a0[3] * s0[3] * bf_hi(gw.y));
                        w.z = cvt_pk_bf16(a1[0] * s1[0] * bf_lo(gw.z), a1[1] * s1[1] * bf_hi(gw.z));
                        w.w = cvt_pk_bf16(a1[2] * s1[2] * bf_lo(gw.w), a1[3] * s1[3] * bf_hi(gw.w));
                        *(u32x4*)(OAP + (size_t)row * 2048 + 1024 + col0 + bj * 128) = w;
                    }
                }
                asm volatile("" ::: "memory");
            }
    }
};
struct EpiT1 {
    static constexpr bool PERM = true;
    const bf16_t* SMA; float* T1;
    __device__ __forceinline__ void operator()(const f32x4 (&acc)[2][2][4][2], const Unit& u, int wr, int wc, int fr, int fq) const {
        const int col0 = u.pn * 256 + wc * 32 + 8 * fq;
#pragma unroll
        for (int ai = 0; ai < 2; ++ai)
#pragma unroll
            for (int m = 0; m < 4; ++m) {
                const int row = u.pm * 256 + ai * 128 + wr * 64 + m * 16 + fr;
                if (row < MROWS) {
#pragma unroll
                    for (int bj = 0; bj < 2; ++bj) {
                        const size_t off = (size_t)row * 2048 + col0 + bj * 128;
                        const u32x4 gw = *(const u32x4*)(SMA + off);
                        const f32x4 a0 = acc[ai][bj][m][0], a1 = acc[ai][bj][m][1];
                        f32x4 o0, o1;
                        o0[0] = a0[0] * bf_lo(gw.x); o0[1] = a0[1] * bf_hi(gw.x); o0[2] = a0[2] * bf_lo(gw.y); o0[3] = a0[3] * bf_hi(gw.y);
                        o1[0] = a1[0] * bf_lo(gw.z); o1[1] = a1[1] * bf_hi(gw.z); o1[2] = a1[2] * bf_lo(gw.w); o1[3] = a1[3] * bf_hi(gw.w);
                        *(f32x4*)(T1 + off) = o0; *(f32x4*)(T1 + off + 4) = o1;
                    }
                }
                asm volatile("" ::: "memory");
            }
    }
};
struct EpiMg {
    static constexpr bool PERM = true;
    const bf16_t* SMP; const float* T1; bf16_t* MG;
    __device__ __forceinline__ void operator()(const f32x4 (&acc)[2][2][4][2], const Unit& u, int wr, int wc, int fr, int fq) const {
        const int col0 = u.pn * 256 + wc * 32 + 8 * fq;
#pragma unroll
        for (int ai = 0; ai < 2; ++ai)
#pragma unroll
            for (int m = 0; m < 4; ++m) {
                const int row = u.pm * 256 + ai * 128 + wr * 64 + m * 16 + fr;
                if (row < MROWS) {
#pragma unroll
                    for (int bj = 0; bj < 2; ++bj) {
                        const size_t off = (size_t)row * 2048 + col0 + bj * 128;
                        const u32x4 gw = *(const u32x4*)(SMP + off);
                        const f32x4 t0 = *(const f32x4*)(T1 + off), t1 = *(const f32x4*)(T1 + off + 4);
                        const f32x4 a0 = acc[ai][bj][m][0], a1 = acc[ai][bj][m][1];
                        u32x4 w;
                        w.x = cvt_pk_bf16(t0[0] + a0[0] * bf_lo(gw.x), t0[1] + a0[1] * bf_hi(gw.x));
                        w.y = cvt_pk_bf16(t0[2] + a0[2] * bf_lo(gw.y), t0[3] + a0[3] * bf_hi(gw.y));
                        w.z = cvt_pk_bf16(t1[0] + a1[0] * bf_lo(gw.z), t1[1] + a1[1] * bf_hi(gw.z));
                        w.w = cvt_pk_bf16(t1[2] + a1[2] * bf_lo(gw.w), t1[3] + a1[3] * bf_hi(gw.w));
                        *(u32x4*)(MG + off) = w;
                    }
                }
                asm volatile("" ::: "memory");
            }
    }
};
struct EpiRes {
    static constexpr bool PERM = true;
    float* XS;
    __device__ __forceinline__ void operator()(const f32x4 (&acc)[2][2][4][2], const Unit& u, int wr, int wc, int fr, int fq) const {
        const int col0 = u.pn * 256 + wc * 32 + 8 * fq;
#pragma unroll
        for (int ai = 0; ai < 2; ++ai)
#pragma unroll
            for (int m = 0; m < 4; ++m) {
                const int row = u.pm * 256 + ai * 128 + wr * 64 + m * 16 + fr;
                if (row < MROWS) {
#pragma unroll
                    for (int bj = 0; bj < 2; ++bj) {
                        const size_t off = (size_t)row * 2048 + col0 + bj * 128;
                        const f32x4 t0 = *(const f32x4*)(XS + off), t1 = *(const f32x4*)(XS + off + 4);
                        *(f32x4*)(XS + off) = t0 + acc[ai][bj][m][0]; *(f32x4*)(XS + off + 4) = t1 + acc[ai][bj][m][1];
                    }
                }
                asm volatile("" ::: "memory");
            }
    }
};

struct Args {
    const float* x; const float* meta; const float* norm_gain; const float* w_in; const float* pool_w; const float* pool_scale;
    const float* w_attn_up; const float* w_pool_up; const float* w_out; const float* final_gain;
    float* out; unsigned char* ws; int ph_lo, ph_hi;
};

__device__ __forceinline__ void transpose_item(const float* W, int N, bf16_t* WT, int ldwt, int coff, LAS float* scr, int kb, int nb, int lane) {
    const int k0 = 64 * kb, n0 = 32 * nb;
    float tv[32];
#pragma unroll
    for (int i = 0; i < 32; ++i) { const int kk = 2 * i + (lane >> 5); tv[i] = W[(size_t)(k0 + kk) * N + n0 + (lane & 31)]; }
#pragma unroll
    for (int i = 0; i < 32; ++i) { const int kk = 2 * i + (lane >> 5); scr[kk * 33 + (lane & 31)] = tv[i]; }
    asm volatile("s_waitcnt lgkmcnt(0)" ::: "memory");
    const int c = lane & 7;
#pragma unroll
    for (int j = 0; j < 4; ++j) { const int n = (lane >> 3) + 8 * j; const LAS float* s = scr + (8 * c) * 33 + n;
        u32x4 o; o.x = cvt_pk_bf16(s[0 * 33], s[1 * 33]); o.y = cvt_pk_bf16(s[2 * 33], s[3 * 33]); o.z = cvt_pk_bf16(s[4 * 33], s[5 * 33]); o.w = cvt_pk_bf16(s[6 * 33], s[7 * 33]);
        *(u32x4*)(WT + (size_t)(n0 + n) * ldwt + coff + k0 + 8 * c) = o; }
    asm volatile("s_waitcnt lgkmcnt(0)" ::: "memory");
}
__device__ __forceinline__ void rms_row_bf16(const float* xrow, const float* gain, bf16_t* orow, float* xs_out, int lane) {
    const f32x4* xr = (const f32x4*)xrow + lane;
    f32x4 v[8]; float s = 0.f;
#pragma unroll
    for (int j = 0; j < 8; ++j) { v[j] = xr[64 * j]; s += (v[j][0] * v[j][0] + v[j][1] * v[j][1]) + (v[j][2] * v[j][2] + v[j][3] * v[j][3]); }
    const float r = 1.0f / sqrtf(wave_sum(s, lane) * (1.0f / DM) + RMS_EPS);
    if (xs_out) {
#pragma unroll
        for (int j = 0; j < 8; ++j) ((f32x4*)xs_out + lane)[64 * j] = v[j];
    }
    const f32x4* gr = (const f32x4*)gain + lane;
    u32x2* o8 = (u32x2*)orow + lane;
#pragma unroll
    for (int j = 0; j < 8; ++j) { const f32x4 g = gr[64 * j]; u32x2 w; w.x = cvt_pk_bf16(v[j][0] * r * g[0], v[j][1] * r * g[1]); w.y = cvt_pk_bf16(v[j][2] * r * g[2], v[j][3] * r * g[3]); o8[64 * j] = w; }
}
__device__ __forceinline__ void rms_row_f32(const float* xrow, const float* gain, float* orow, int lane) {
    const f32x4* xr = (const f32x4*)xrow + lane;
    f32x4 v[8]; float s = 0.f;
#pragma unroll
    for (int j = 0; j < 8; ++j) { v[j] = xr[64 * j]; s += (v[j][0] * v[j][0] + v[j][1] * v[j][1]) + (v[j][2] * v[j][2] + v[j][3] * v[j][3]); }
    const float r = 1.0f / sqrtf(wave_sum(s, lane) * (1.0f / DM) + RMS_EPS);
    const f32x4* gr = (const f32x4*)gain + lane;
#pragma unroll
    for (int j = 0; j < 8; ++j) { const f32x4 g = gr[64 * j]; ((f32x4*)orow + lane)[64 * j] = v[j] * r * g; }
}

constexpr int KS = 272;
constexpr int TILEB = 64 * KS;
__device__ __forceinline__ float fexp2(float x) { return __builtin_amdgcn_exp2f(x); }
__device__ __forceinline__ float frcp(float x) { return __builtin_amdgcn_rcpf(x); }

__device__ __forceinline__ void attn_unit(LAS unsigned char* lds, const bf16_t* __restrict__ QB, const bf16_t* __restrict__ KB, const bf16_t* __restrict__ VB,
                                          const bf16_t* __restrict__ GA, bf16_t* __restrict__ OAP, int b, int h, int qb) {
    const int tid = tid_fresh(), w = __builtin_amdgcn_readfirstlane(tid >> 6), l = tid & 63, qi = l & 15, lg = l >> 4;
    const int tq0 = 64 + 128 * qb + 16 * w;
    const bool wactive = (tq0 >= TOFF);
    const int tq = tq0 + qi;
    const int mrow = (tq0 >= 64) ? (b * 2048 + tq - 64) : (MREAL + 16 * b + (wactive ? tq - TOFF : 0));
    const int jtop = (qb >= 0) ? 2 * qb + 2 : 0, ntiles = jtop + 1;
    const int jw = wactive ? ((tq0 + 14) >> 6) : -1;
    bf16x8 qf[4];
#pragma unroll
    for (int dc = 0; dc < 4; ++dc) qf[dc] = *(const bf16x8*)(QB + (size_t)mrow * 1024 + h * 128 + dc * 32 + lg * 8);
    f32x4 o[8];
#pragma unroll
    for (int dg = 0; dg < 8; ++dg) o[dg] = (f32x4){0.f, 0.f, 0.f, 0.f};
    float P = 1.0f;
    const size_t gbase = ((size_t)b * LP) * 1024 + h * 128;
    u32x4 kreg[2], vreg[2];
    auto gload = [&](int j) {
#pragma unroll
        for (int i = 0; i < 2; ++i) { const int p = tid + 512 * i, r = p >> 4, c = p & 15; const size_t off = gbase + (size_t)(64 * j + r) * 1024 + c * 8;
            kreg[i] = *(const u32x4*)(KB + off); vreg[i] = *(const u32x4*)(VB + off); }
    };
    auto lwrite = [&](int buf) {
#pragma unroll
        for (int i = 0; i < 2; ++i) { const int p = tid + 512 * i, r = p >> 4, c = p & 15;
            *(LAS u32x4*)(lds + buf * 2 * TILEB + r * KS + c * 16) = kreg[i]; *(LAS u32x4*)(lds + buf * 2 * TILEB + TILEB + r * KS + c * 16) = vreg[i]; }
    };
    LAS volatile int* flags = (LAS volatile int*)(lds + MISC_OFF + 64);
    gload(jtop); lwrite(0);
    __syncthreads();
    const int kbase = (16 * (qi >> 2) + (qi & 3)) * KS + lg * 16;
    const int vbase = (16 * lg + (qi >> 2)) * KS + (qi & 3) * 8;
    for (int it = 0; it < ntiles; ++it) {
        const int j = jtop - it, cur = it & 1;
        if (it + 1 < ntiles) gload(j - 1);
        if (j <= jw) {
            LAS unsigned char* Kb = lds + cur * 2 * TILEB; LAS unsigned char* Vb = Kb + TILEB;
            f32x4 s[4];
            float zf = 0.f; asm volatile("" : "+v"(zf));
#pragma unroll
            for (int g = 0; g < 4; ++g) s[g] = (f32x4){zf, zf, zf, zf};
#pragma unroll
            for (int dc = 0; dc < 4; ++dc)
#pragma unroll
                for (int g = 0; g < 4; ++g) { const bf16x8 kf = *(const LAS bf16x8*)(Kb + kbase + g * 4 * KS + dc * 64); s[g] = __builtin_amdgcn_mfma_f32_16x16x32_bf16(kf, qf[dc], s[g], 0, 0, 0); }
            const bool need_mask = (64 * j + 63 >= tq0) || (j == 0);
            float beta[16], omb[16];
#pragma unroll
            for (int kk = 0; kk < 16; ++kk) {
                const float z = fmaxf(s[kk >> 2][kk & 3], -60.0f);
                const float t = fexp2(-z), r = frcp(1.0f + t);
                beta[kk] = r; omb[kk] = t * r;
            }
            if (need_mask) {
                const int tk0 = 64 * j + 16 * lg;
#pragma unroll
                for (int kk = 0; kk < 16; ++kk) { const int tk = tk0 + kk; const bool valid = (tk >= TOFF) && (tk < tq); beta[kk] = valid ? beta[kk] : 0.0f; omb[kk] = valid ? omb[kk] : 1.0f; }
            }
            float e[16]; e[15] = 1.0f;
#pragma unroll
            for (int kk = 14; kk >= 0; --kk) e[kk] = e[kk + 1] * omb[kk + 1];
            const float T = e[0] * omb[0];
            const float T1 = shfl_idx(T, (l + 16) & 63), T2 = shfl_idx(T, (l + 32) & 63), T3 = shfl_idx(T, (l + 48) & 63);
            float G = 1.0f;
            if (lg <= 2) G *= T1;
            if (lg <= 1) G *= T2;
            if (lg == 0) G *= T3;
            const float c = P * G;
            P = P * ((T * T1) * (T2 * T3));
            float a[16];
#pragma unroll
            for (int kk = 0; kk < 16; ++kk) a[kk] = beta[kk] * (e[kk] * c);
            bf16x8 pa[2];
#pragma unroll
            for (int mm = 0; mm < 2; ++mm) {
                u32x4 wv; wv.x = cvt_pk_bf16(a[8 * mm + 0], a[8 * mm + 1]); wv.y = cvt_pk_bf16(a[8 * mm + 2], a[8 * mm + 3]); wv.z = cvt_pk_bf16(a[8 * mm + 4], a[8 * mm + 5]); wv.w = cvt_pk_bf16(a[8 * mm + 6], a[8 * mm + 7]);
                pa[mm] = __builtin_bit_cast(bf16x8, wv);
            }
#pragma unroll
            for (int dg = 0; dg < 8; ++dg)
#pragma unroll
                for (int mm = 0; mm < 2; ++mm) {
                    const s16x4 v0 = __builtin_bit_cast(s16x4, __builtin_amdgcn_ds_read_tr16_b64_v4i16((LAS s16x4*)(Vb + vbase + (8 * mm) * KS + dg * 32)));
                    const s16x4 v1 = __builtin_bit_cast(s16x4, __builtin_amdgcn_ds_read_tr16_b64_v4i16((LAS s16x4*)(Vb + vbase + (8 * mm + 4) * KS + dg * 32)));
                    bf16x8 vf; vf[0] = v0[0]; vf[1] = v0[1]; vf[2] = v0[2]; vf[3] = v0[3]; vf[4] = v1[0]; vf[5] = v1[1]; vf[6] = v1[2]; vf[7] = v1[3];
                    o[dg] = __builtin_amdgcn_mfma_f32_16x16x32_bf16(vf, pa[mm], o[dg], 0, 0, 0);
                }
        }
        if (it + 1 < ntiles) lwrite(cur ^ 1);
        { const bool wdone = !wactive || (j <= jw && __builtin_amdgcn_ballot_w64(P != 0.0f) == 0ull);
          if (l == 0) flags[(it & 1) * 8 + w] = wdone ? 1 : 0; }
        __syncthreads();
        { int alld = 1;
#pragma unroll
          for (int ww = 0; ww < 8; ++ww) alld &= flags[(it & 1) * 8 + ww];
          if (alld) break; }
    }
    if (wactive) {
#pragma unroll
        for (int dg = 0; dg < 8; ++dg) {
            const size_t col = (size_t)h * 128 + 16 * dg + 4 * lg;
            const u32x2 gw = *(const u32x2*)(GA + (size_t)mrow * 1024 + col);
            u32x2 wv; wv.x = cvt_pk_bf16(o[dg][0] * bf_lo(gw.x), o[dg][1] * bf_hi(gw.x)); wv.y = cvt_pk_bf16(o[dg][2] * bf_lo(gw.y), o[dg][3] * bf_hi(gw.y));
            *(u32x2*)(OAP + (size_t)mrow * 2048 + col) = wv;
        }
    }
}

__device__ __forceinline__ void load8f(const bf16_t* p, float (&f)[8]) {
    const u32x4 w = *(const u32x4*)p;
    f[0] = bf_lo(w.x); f[1] = bf_hi(w.x); f[2] = bf_lo(w.y); f[3] = bf_hi(w.y); f[4] = bf_lo(w.z); f[5] = bf_hi(w.z); f[6] = bf_lo(w.w); f[7] = bf_hi(w.w);
}
__device__ __forceinline__ void pool_unit(LAS unsigned char* lds, const bf16_t* __restrict__ UB, bf16_t* __restrict__ PL, const bf16_t* PWT  , const float* scale  ,
                                          const bf16_t* GP, bf16_t* OAP, int pm, int g) {
    const int tid = tid_fresh(), cc = tid & 31, strip = tid >> 5;
    const int w = 2 << g;
    int b, tb, m0; bool valid = true;
    if (pm < 32) { const int r0 = pm * 256 + strip * 16; b = r0 >> 11; tb = 64 + (r0 & 2047); m0 = r0; }
    else { b = strip & 3; tb = TOFF; m0 = MREAL + 16 * (strip & 3); valid = strip < 4; }
    if (valid) {
        const bf16_t* up = UB + ((size_t)(b * LP + tb)) * 1024 + g * 256 + cc * 8;
        float S[8];
#pragma unroll
        for (int e = 0; e < 8; ++e) S[e] = 0.f;
        for (int j = 1; j < w; ++j) { float f[8]; load8f(up - (size_t)j * 1024, f);
#pragma unroll
            for (int e = 0; e < 8; ++e) S[e] += f[e]; }
        for (int rr = 0; rr < 16; ++rr) {
            float cu[8]; load8f(up + (size_t)rr * 1024, cu);
            if (rr > 0) { float f[8]; load8f(up + (size_t)(rr - w) * 1024, f);
#pragma unroll
                for (int e = 0; e < 8; ++e) S[e] -= f[e]; }
#pragma unroll
            for (int e = 0; e < 8; ++e) S[e] += cu[e];
            const int t = tb + rr - TOFF; const float inv = 1.0f / (float)((t + 1) < w ? (t + 1) : w);
            u32x4 o; o.x = cvt_pk_bf16(S[0] * inv - cu[0], S[1] * inv - cu[1]); o.y = cvt_pk_bf16(S[2] * inv - cu[2], S[3] * inv - cu[3]);
            o.z = cvt_pk_bf16(S[4] * inv - cu[4], S[5] * inv - cu[5]); o.w = cvt_pk_bf16(S[6] * inv - cu[6], S[7] * inv - cu[7]);
            *(u32x4*)(PL + (size_t)(m0 + rr) * 1024 + g * 256 + cc * 8) = o;
        }
    }
    __threadfence();
    __syncthreads();
    pg8::Gemm gm{PL + g * 256, PWT + (size_t)g * GD * GD, 1024, 256, 256};
    pg8::OneUnit S1{{pm, 0}};
    EpiPool E{scale, GP, OAP, g};
    pg8::gemm_phase<EpiPool, pg8::OneUnit, true, true>(lds, gm, S1, E);
}

constexpr int PH_PRO = 0, PH_FINAL = 1 + 5 * DEPTH, N_PHASES = PH_FINAL + 1;
constexpr int N_ATT = 32 * 16, N_POOLU = 33 * 4, N_METAU = 32, N_BITEMS = N_ATT + N_POOLU + N_METAU;

#define TID_VARS() const int tid = tid_fresh(), lane = tid & 63, wave = __builtin_amdgcn_readfirstlane(tid >> 6); const int gw = bx * 8 + wave, NGW = G * 8; (void)lane; (void)gw; (void)NGW; (void)tid;
#define WS_PTRS() \
    unsigned char* ws = args.ws; asm volatile("" : "+s"(ws)); \
    unsigned* ctl = (unsigned*)(ws + WS_CTL); (void)ctl; \
    float* XS = (float*)(ws + WS_XS); bf16_t* HB = (bf16_t*)(ws + WS_HB); (void)XS; (void)HB; \
    bf16_t* WIN = (bf16_t*)(ws + WS_WIN); bf16_t* WM = (bf16_t*)(ws + WS_WM); bf16_t* WO = (bf16_t*)(ws + WS_WO); bf16_t* PWT = (bf16_t*)(ws + WS_PW); (void)WIN; (void)WM; (void)WO; (void)PWT; \
    bf16_t* QB = (bf16_t*)(ws + WS_QB); bf16_t* KB = (bf16_t*)(ws + WS_KB); bf16_t* VB = (bf16_t*)(ws + WS_VB); bf16_t* UB = (bf16_t*)(ws + WS_UB); (void)QB; (void)KB; (void)VB; (void)UB; \
    bf16_t* GA = (bf16_t*)(ws + WS_GA); bf16_t* GP = (bf16_t*)(ws + WS_GP); bf16_t* SMA = (bf16_t*)(ws + WS_SMA); bf16_t* SMP = (bf16_t*)(ws + WS_SMP); (void)GA; (void)GP; (void)SMA; (void)SMP; \
    bf16_t* OAP = (bf16_t*)(ws + WS_OAP); bf16_t* PL = (bf16_t*)(ws + WS_PL); float* T1 = (float*)(ws + WS_T1); bf16_t* MG = (bf16_t*)(ws + WS_MG); (void)OAP; (void)PL; (void)T1; (void)MG;
__global__ void __launch_bounds__(512, 2) mega_fwd(Args args) {
    extern __shared__ __attribute__((aligned(16))) unsigned char lds_raw[];
    LAS unsigned char* lds = (LAS unsigned char*)lds_raw;
    cg::grid_group grid = cg::this_grid();
    const int G = gridDim.x, bx = blockIdx.x;
    for (int ph = args.ph_lo; ph < args.ph_hi; ++ph) {
        if (ph == PH_PRO) {
            WS_PTRS(); TID_VARS();

#ifndef DIS_PRO
            LAS float* scr = (LAS float*)(lds + wave * 8704);
            constexpr int I_IN = 32 * 320, I_UP = 16 * 64, I_OUT = 32 * 64, I_PW = 4 * 8;
            constexpr int PER_L = I_IN + 2 * I_UP + I_OUT + 4 * I_PW;
            for (int it = gw; it < DEPTH * PER_L; it += NGW) {
                const int L = it / PER_L; int r = it % PER_L;
                if (r < I_IN) { transpose_item(args.w_in + (size_t)L * DM * INC, INC, WIN + (size_t)L * INC * DM, DM, 0, scr, r / 320, r % 320, lane); continue; } r -= I_IN;
                if (r < I_UP) { transpose_item(args.w_attn_up + (size_t)L * SBW * DM, DM, WM + (size_t)L * DM * DM, DM, 0, scr, r / 64, r % 64, lane); continue; } r -= I_UP;
                if (r < I_UP) { transpose_item(args.w_pool_up + (size_t)L * PWD * DM, DM, WM + (size_t)L * DM * DM, DM, 1024, scr, r / 64, r % 64, lane); continue; } r -= I_UP;
                if (r < I_OUT) { transpose_item(args.w_out + (size_t)L * DM * DM, DM, WO + (size_t)L * DM * DM, DM, 0, scr, r / 64, r % 64, lane); continue; } r -= I_OUT;
                { const int gq = r / I_PW, rr = r % I_PW; transpose_item(args.pool_w + ((size_t)L * 4 + gq) * GD * GD, GD, PWT + ((size_t)L * 4 + gq) * GD * GD, GD, 0, scr, rr / 8, rr % 8, lane); }
            }
            for (int m = gw; m < MROWS; m += NGW) {
                const float* src = (m < MREAL) ? args.x + (size_t)m * DM : args.meta + (size_t)((m - MREAL) & 15) * DM;
                rms_row_bf16(src, args.norm_gain, HB + (size_t)m * DM, XS + (size_t)m * DM, lane);
            }
            { unsigned zu = 0u; asm volatile("" : "+v"(zu)); const int gt = bx * 512 + tid, NGT = G * 512; constexpr int PIECES = NB * TOFF * 128;
              for (int p = gt; p < 3 * PIECES; p += NGT) { const int bufi = p / PIECES, q = p % PIECES, bb = q / (TOFF * 128), rem = q % (TOFF * 128);
                  bf16_t* base = bufi == 0 ? KB : (bufi == 1 ? VB : UB);
                  *(u32x4*)(base + (size_t)bb * LP * 1024 + (size_t)rem * 8) = (u32x4){zu, zu, zu, zu}; } }
            if (bx == 0 && tid < 64) ctl[tid] = 0u;
#endif

        } else if (ph == PH_FINAL) {
            WS_PTRS(); TID_VARS();
            for (int m = gw; m < MREAL; m += NGW) rms_row_f32(XS + (size_t)m * DM, args.final_gain, args.out + (size_t)m * DM, lane);
        } else {
            const int L = (ph - 1) / 5, sub = (ph - 1) % 5;
            if (sub == 0) {
                WS_PTRS(); TID_VARS();
                if (L > 0) for (int m = gw; m < MROWS; m += NGW) rms_row_bf16(XS + (size_t)m * DM, args.norm_gain + (size_t)L * DM, HB + (size_t)m * DM, nullptr, lane);
            } else if (sub == 1) {
                WS_PTRS();

#ifndef DIS_A
                pg8::Gemm g{HB, WIN + (size_t)L * INC * DM, DM, DM, DM}; pg8::StaticOrder S; S.init(MPAD, INC, G, bx);
                EpiIn E{QB, KB, VB, UB, GA, GP, SMA, SMP};
                pg8::gemm_phase<EpiIn, pg8::StaticOrder, true, true>(lds, g, S, E);
#endif

            } else if (sub == 2) {
                WS_PTRS();
                LAS volatile int* item_s = (LAS volatile int*)(lds + MISC_OFF);
                for (;;) {
                    __syncthreads();
                    if (tid_fresh() == 0) *item_s = (int)atomicAdd(ctl + L, 1u);
                    __syncthreads();
                    const int item = *item_s;
                    if (item >= N_BITEMS) break;

#ifndef DIS_B
                    if (item < N_ATT || item >= N_ATT + N_POOLU) {
#ifndef DIS_ATT
                        const int qb = item < N_ATT ? 15 - item / 32 : -1, bh = item < N_ATT ? item % 32 : item - N_ATT - N_POOLU;
                        attn_unit(lds, QB, KB, VB, GA, OAP, bh >> 3, bh & 7, qb);
#endif
                    } else {
#ifndef DIS_POOL
                        const int r = item - N_ATT; pool_unit(lds, UB, PL, PWT + (size_t)L * 4 * GD * GD, args.pool_scale + (size_t)L * PWD, GP, OAP, r >> 2, r & 3);
#endif
                    }
#endif

                }
            } else if (sub == 3) {
                WS_PTRS();
                pg8::StaticOrder S; S.init(MPAD, DM, G, bx);

#ifndef DIS_C
                { pg8::Gemm g{OAP, WM + (size_t)L * DM * DM, DM, DM, 1024}; EpiT1 E{SMA, T1}; pg8::gemm_phase<EpiT1, pg8::StaticOrder, true, true>(lds, g, S, E); }
                { pg8::Gemm g{OAP + 1024, WM + (size_t)L * DM * DM + 1024, DM, DM, 1024}; EpiMg E{SMP, T1, MG}; pg8::gemm_phase<EpiMg, pg8::StaticOrder, true, true>(lds, g, S, E); }
#endif

            } else {
                WS_PTRS();
#ifndef DIS_D
                pg8::Gemm g{MG, WO + (size_t)L * DM * DM, DM, DM, DM}; pg8::StaticOrder S; S.init(MPAD, DM, G, bx);
                EpiRes E{XS};
                pg8::gemm_phase<EpiRes, pg8::StaticOrder, true, true>(lds, g, S, E);
#endif

            }
        }
        if (ph + 1 < args.ph_hi) grid.sync();
    }
}

extern "C" void kernel_launch(void* const* d_in, const int* in_sizes, int n_in, void* d_out, int out_size, void* d_ws, size_t ws_size, hipStream_t stream) {
    static int grid = 0;
    if (grid == 0) {
        if (n_in != 10 || ws_size < WS_END) { fprintf(stderr, "kernel_launch: need 10 inputs and >= %zu bytes of workspace (got %d, %zu)\n", (size_t)WS_END, n_in, ws_size); grid = -1; return; }
        int dev = 0, cus = 0, per_cu = 0;
        hipGetDevice(&dev); hipDeviceGetAttribute(&cus, hipDeviceAttributeMultiprocessorCount, dev);
        if (hipFuncSetAttribute((const void*)mega_fwd, hipFuncAttributeMaxDynamicSharedMemorySize, LDS_BYTES) != hipSuccess) { fprintf(stderr, "kernel_launch: hipFuncSetAttribute failed\n"); grid = -1; return; }
        if (hipOccupancyMaxActiveBlocksPerMultiprocessor(&per_cu, (const void*)mega_fwd, 512, LDS_BYTES) != hipSuccess || per_cu < 1) { fprintf(stderr, "kernel_launch: occupancy query gave %d\n", per_cu); per_cu = 1; }
        (void)hipGetLastError();
        grid = cus * per_cu;
    }
    if (grid < 0) return;
    Args a{};
    a.x = (const float*)d_in[0]; a.meta = (const float*)d_in[1]; a.norm_gain = (const float*)d_in[2]; a.w_in = (const float*)d_in[3]; a.pool_w = (const float*)d_in[4];
    a.pool_scale = (const float*)d_in[5]; a.w_attn_up = (const float*)d_in[6]; a.w_pool_up = (const float*)d_in[7]; a.w_out = (const float*)d_in[8]; a.final_gain = (const float*)d_in[9];
    a.out = (float*)d_out; a.ws = (unsigned char*)d_ws;
#if MK_MULTI
    for (int ph = 0; ph < N_PHASES; ++ph) {
        if (ph >= 1 && ph < PH_FINAL && (ph - 1) % 5 == 0 && (ph - 1) / 5 == 0) continue;
        a.ph_lo = ph; a.ph_hi = ph + 1;
        hipLaunchKernelGGL(mega_fwd, dim3(grid), dim3(512), LDS_BYTES, stream, a);
    }
#else
    a.ph_lo = 0; a.ph_hi = N_PHASES;
    void* kargs[] = {&a};
    hipError_t e = hipLaunchCooperativeKernel((const void*)mega_fwd, dim3(grid), dim3(512), kargs, LDS_BYTES, stream);
    if (e != hipSuccess) fprintf(stderr, "cooperative launch failed: %s (grid %d)\n", hipGetErrorString(e), grid);
#endif
}
```

```cpp
#include <hip/hip_runtime.h>
#include <hip/hip_cooperative_groups.h>
#include <cstdio>
#include <cstdint>
namespace cg = cooperative_groups;

#ifndef REP_PRO
#define REP_PRO 1
#endif
#ifndef REP_A
#define REP_A 1
#endif
#ifndef REP_B
#define REP_B 1
#endif
#ifndef REP_C
#define REP_C 1
#endif
#ifndef MK_MULTI
#define MK_MULTI 0
#endif

#define LAS __attribute__((address_space(3)))
typedef unsigned short bf16_t;
typedef short bf16x8 __attribute__((ext_vector_type(8)));
typedef short s16x4 __attribute__((ext_vector_type(4)));
typedef float f32x4 __attribute__((ext_vector_type(4)));
typedef unsigned u32x4 __attribute__((ext_vector_type(4)));
typedef unsigned u32x2 __attribute__((ext_vector_type(2)));

constexpr int DM = 2048, NB = 4, SEQ = 2048, DEPTH = 4, NMETA = 16, NH = 8, DH = 128, SBW = 1024, PWD = 1024, GD = 256, INC = 10240;
constexpr int MREAL = NB * SEQ;
constexpr int MROWS = MREAL + NMETA;
constexpr int MPAD = 8448;
constexpr int LP = 2176;
constexpr int TOFF = 48;
constexpr float RMS_EPS = 1e-6f;
constexpr float LOG2E = 1.4426950408889634f;
constexpr float QSCALE = 0.08838834764831845f * LOG2E;

constexpr size_t al256(size_t x) { return (x + 255) & ~(size_t)255; }
constexpr size_t WS_CTL = 0;
constexpr size_t WS_XS = 4096;
constexpr size_t WS_HB = al256(WS_XS + (size_t)MPAD * DM * 4);
constexpr size_t WS_WIN = al256(WS_HB + (size_t)MPAD * DM * 2);
constexpr size_t WS_WM = al256(WS_WIN + (size_t)DEPTH * INC * DM * 2);
constexpr size_t WS_WO = al256(WS_WM + (size_t)DEPTH * DM * DM * 2);
constexpr size_t WS_PW = al256(WS_WO + (size_t)DEPTH * DM * DM * 2);
constexpr size_t WS_QB = al256(WS_PW + (size_t)DEPTH * 4 * GD * GD * 2);
constexpr size_t WS_KB = al256(WS_QB + (size_t)MPAD * 1024 * 2);
constexpr size_t WS_VB = al256(WS_KB + (size_t)NB * LP * 1024 * 2);
constexpr size_t WS_UB = al256(WS_VB + (size_t)NB * LP * 1024 * 2);
constexpr size_t WS_GA = al256(WS_UB + (size_t)NB * LP * 1024 * 2);
constexpr size_t WS_GP = al256(WS_GA + (size_t)MPAD * 1024 * 2);
constexpr size_t WS_SMA = al256(WS_GP + (size_t)MPAD * 1024 * 2);
constexpr size_t WS_SMP = al256(WS_SMA + (size_t)MPAD * DM * 2);
constexpr size_t WS_OAP = al256(WS_SMP + (size_t)MPAD * DM * 2);
constexpr size_t WS_PL = al256(WS_OAP + (size_t)MPAD * DM * 2);
constexpr size_t WS_T1 = al256(WS_PL + (size_t)MPAD * 1024 * 2);
constexpr size_t WS_MG = al256(WS_T1 + (size_t)MPAD * DM * 4);
constexpr size_t WS_END = al256(WS_MG + (size_t)MPAD * DM * 2);

constexpr int LDS_BYTES = 147456;
constexpr int RING_BYTES = 131072;
constexpr int MISC_OFF = RING_BYTES;

__device__ __forceinline__ unsigned cvt_pk_bf16(float lo, float hi) { unsigned r; asm volatile("v_cvt_pk_bf16_f32 %0, %1, %2" : "=v"(r) : "v"(lo), "v"(hi)); return r; }
__device__ __forceinline__ int tid_fresh() { int t = threadIdx.x; asm volatile("" : "+v"(t)); return t; }
__device__ __forceinline__ const char* uni_ptr(const char* p) {
    const unsigned long long v = (unsigned long long)p;
    const unsigned lo = __builtin_amdgcn_readfirstlane((unsigned)v), hi = __builtin_amdgcn_readfirstlane((unsigned)(v >> 32));
    return (const char*)(((unsigned long long)hi << 32) | lo);
}
__device__ __forceinline__ float bf_lo(unsigned w) { return __uint_as_float(w << 16); }
__device__ __forceinline__ float bf_hi(unsigned w) { return __uint_as_float(w & 0xffff0000u); }
__device__ __forceinline__ float fsigmoid(float v) { return __builtin_amdgcn_rcpf(1.0f + __builtin_amdgcn_exp2f(-v * LOG2E)); }
__device__ __forceinline__ float shfl_idx(float v, int srclane) { return __int_as_float(__builtin_amdgcn_ds_bpermute(srclane << 2, __float_as_int(v))); }
__device__ __forceinline__ float wave_sum(float v, int lane) {
#pragma unroll
    for (int o = 1; o < 64; o <<= 1) v += shfl_idx(v, lane ^ o);
    return v;
}
__device__ __forceinline__ int btrow(int row) {
    return (row >> 11) * LP + 64 + (row & 2047);
}

namespace pg8 {
constexpr int BM = 256, BK = 64, HALF = 128, HTB = HALF * BK * 2, STAGE_BYTES = 8 * HTB, NXCD = 8, WGM = 8;
__host__ __device__ __forceinline__ int lds_byte(int r, int c) { const int st = (r >> 4) * 2 + (c >> 5), rr = r & 15, cc = c & 31, ob = rr * 64 + cc * 2; return st * 1024 + (ob ^ (((ob >> 9) & 1) << 5)); }
__host__ __device__ __forceinline__ void stage_rc(int b, int& R, int& C) { const int st = b / 1024, sb = b % 1024, swz = sb ^ (((sb >> 9) & 1) << 5); R = (st >> 1) * 16 + swz / 64; C = (st & 1) * 32 + (swz % 64) / 2; }
__host__ __device__ __forceinline__ int perm32(int rho) { const int n = rho >> 4, i = rho & 15; return 8 * (i >> 2) + 4 * n + (i & 3); }

struct Unit { int pm, pn; };
struct Gemm { const bf16_t* A; const bf16_t* Bt; };

struct StaticOrder {
    int nM, nN, nwg, G, c;
    __host__ __device__ void init(int M, int N, int G_, int c_) { nM = M / BM; nN = N / BM; nwg = nM * nN; G = G_; c = c_; }
    __host__ __device__ bool next(int i, Unit& u) const {
        const long L = (long)i * G + c; if (L >= nwg) return false;
        int wgid = (int)L; { const int q = nwg / NXCD, r = nwg % NXCD, xcd = wgid % NXCD, off = wgid / NXCD; wgid = (xcd < r ? xcd * (q + 1) : r * (q + 1) + (xcd - r) * q) + off; }
        const int nig = WGM * nN, gid = wgid / nig, fm = gid * WGM, gsz = (nM - fm) < WGM ? (nM - fm) : WGM;
        u.pm = fm + ((wgid % nig) % gsz); u.pn = (wgid % nig) / gsz; return true;
    }
};
struct OneUnit {
    Unit u;
    __device__ bool next(int i, Unit& o) const { if (i) return false; o = u; return true; }
};

template <class Epi, class Sched, int LDA, int LDB, int KK, bool ALIGN_EPI = true, bool SP2 = true>
__device__ __forceinline__ void gemm_phase(LAS unsigned char* lds, const Gemm g, const Sched& S, const Epi& E) {
    const int tid = tid_fresh(), wid = __builtin_amdgcn_readfirstlane(tid >> 6), lane = tid & 63, wr = wid >> 2, wc = wid & 3, fr = lane & 15, fq = lane >> 4;
    constexpr int nt = KK / BK;
    unsigned voffA[2], voffB[2];
#pragma unroll
    for (int i = 0; i < 2; ++i) { int R, C; stage_rc(tid * 16 + i * 8192, R, C); const int Rb = Epi::PERM ? ((R & ~31) + perm32(R & 31)) : R;
        voffA[i] = (unsigned)(R * LDA + C) * 2u; voffB[i] = (unsigned)(Rb * LDB + C) * 2u; }
    constexpr size_t kstep = (size_t)(BK * 2);
    constexpr size_t hstepA = (size_t)HALF * LDA * 2, hstepB = (size_t)HALF * LDB * 2;
    constexpr size_t tstepA = 2 * hstepA, tstepB = 2 * hstepB;
    const unsigned ldsw = (unsigned)wid * 1024u;
    const unsigned ldsbase = (unsigned)(size_t)lds + ldsw;
    const int aoff = lds_byte(wr * 64 + fr, fq * 8), boff = lds_byte(wc * 32 + fr, fq * 8);
#define PG8_SA(b, h) (((b) * 2 + (h)) * HTB)
#define PG8_SB(b, h) ((4 + (b) * 2 + (h)) * HTB)
#define PG8_STAGE(bufoff, gbase, voff) do { _Pragma("unroll") for (int _i = 0; _i < 2; ++_i) \
        asm volatile("s_mov_b32 m0, %2\n\ts_nop 0\n\tglobal_load_lds_dwordx4 %0, %1" :: "v"((voff)[_i]), "s"(uni_ptr((const char*)(gbase))), "s"(ldsbase + (unsigned)((bufoff) + _i * 8192)) : "memory", "m0"); } while (0)
#define PG8_LDA(dst, b, h) do { _Pragma("unroll") for (int m = 0; m < 4; ++m) _Pragma("unroll") for (int k = 0; k < 2; ++k) dst[m][k] = *(const LAS bf16x8*)(lds + PG8_SA(b, h) + aoff + m * 2048 + k * 1024); } while (0)
#define PG8_LDB(dst, b, h) do { _Pragma("unroll") for (int n = 0; n < 2; ++n) _Pragma("unroll") for (int k = 0; k < 2; ++k) dst[n][k] = *(const LAS bf16x8*)(lds + PG8_SB(b, h) + boff + n * 2048 + k * 1024); } while (0)
#define PG8_MMA(ai, bj, At, Bt) do { __builtin_amdgcn_s_setprio(1); _Pragma("unroll") for (int m = 0; m < 4; ++m) _Pragma("unroll") for (int n = 0; n < 2; ++n) _Pragma("unroll") for (int k = 0; k < 2; ++k) \
        acc[ai][bj][m][n] = __builtin_amdgcn_mfma_f32_16x16x32_bf16(Bt[n][k], At[m][k], acc[ai][bj][m][n], 0, 0, 0); __builtin_amdgcn_s_setprio(0); } while (0)
#define PG8_WAIT_V(n) asm volatile("s_waitcnt vmcnt(" #n ")" ::: "memory")
#define PG8_WAIT_L(n) asm volatile("s_waitcnt lgkmcnt(" #n ")" ::: "memory")
#define PG8_BAR __builtin_amdgcn_s_barrier()
#define PG8_SCHED __builtin_amdgcn_sched_barrier(0)
    Unit cur, nxt; int ui = 0;
    if (!S.next(0, cur)) return;
    f32x4 acc[2][2][4][2];
#pragma unroll
    for (int a = 0; a < 2; ++a)
#pragma unroll
        for (int b = 0; b < 2; ++b)
#pragma unroll
            for (int m = 0; m < 4; ++m)
#pragma unroll
                for (int n = 0; n < 2; ++n) acc[a][b][m][n] = (f32x4){0.f, 0.f, 0.f, 0.f};
    bf16x8 At[4][2], B0[2][2], B1[2][2];
    const char* cA = (const char*)g.A + (size_t)cur.pm * tstepA; const char* cB = (const char*)g.Bt + (size_t)cur.pn * tstepB;
    if constexpr (SP2) {
        PG8_STAGE(PG8_SB(0, 0), cB, voffB); PG8_STAGE(PG8_SB(0, 1), cB + hstepB, voffB); PG8_STAGE(PG8_SA(0, 0), cA, voffA); PG8_STAGE(PG8_SA(0, 1), cA + hstepA, voffA);
        if (wr == 1) PG8_BAR;
        PG8_WAIT_V(2); PG8_BAR;
        PG8_STAGE(PG8_SB(1, 0), cB + kstep, voffB); PG8_STAGE(PG8_SA(1, 0), cA + kstep, voffA); PG8_STAGE(PG8_SB(1, 1), cB + hstepB + kstep, voffB);
        PG8_WAIT_V(6); PG8_BAR;
    } else {
        PG8_STAGE(PG8_SB(0, 0), cB, voffB); PG8_STAGE(PG8_SA(0, 0), cA, voffA); PG8_STAGE(PG8_SB(0, 1), cB + hstepB, voffB); PG8_STAGE(PG8_SA(0, 1), cA + hstepA, voffA);
        if (wr == 1) PG8_BAR;
        PG8_WAIT_V(4); PG8_BAR;
        PG8_STAGE(PG8_SB(1, 0), cB + kstep, voffB); PG8_STAGE(PG8_SA(1, 0), cA + kstep, voffA); PG8_STAGE(PG8_SB(1, 1), cB + hstepB + kstep, voffB);
        PG8_WAIT_V(6); PG8_BAR;
    }
    for (;;) {
        const bool has_next = S.next(ui + 1, nxt);
        const char* nA = has_next ? (const char*)g.A + (size_t)nxt.pm * tstepA : cA; const char* nB = has_next ? (const char*)g.Bt + (size_t)nxt.pn * tstepB : cB;
        for (int t = 0; t < nt; t += 2) {
            const bool last = (t == nt - 2);
            const char* a1 = cA + (size_t)(t + 1) * kstep;
            const char* a2 = last ? nA : cA + (size_t)(t + 2) * kstep; const char* b2 = last ? nB : cB + (size_t)(t + 2) * kstep;
            const char* a3 = a2 + kstep; const char* b3 = b2 + kstep;
            if constexpr (SP2) {
            PG8_LDB(B0, 0, 0); PG8_LDB(B1, 0, 1); PG8_SCHED; PG8_LDA(At, 0, 0); PG8_STAGE(PG8_SA(1, 1), a1 + hstepA, voffA);
            PG8_WAIT_V(8); PG8_WAIT_L(0); PG8_BAR; PG8_MMA(0, 0, At, B0); PG8_MMA(0, 1, At, B1); PG8_BAR; PG8_SCHED;
            PG8_LDA(At, 0, 1); PG8_STAGE(PG8_SB(0, 0), b2, voffB); PG8_STAGE(PG8_SB(0, 1), b2 + hstepB, voffB); PG8_STAGE(PG8_SA(0, 0), a2, voffA);
            PG8_WAIT_V(8); PG8_WAIT_L(0); PG8_BAR; PG8_MMA(1, 0, At, B0); PG8_MMA(1, 1, At, B1); PG8_BAR; PG8_SCHED;
            PG8_LDB(B0, 1, 0); PG8_LDB(B1, 1, 1); PG8_SCHED; PG8_LDA(At, 1, 0); PG8_STAGE(PG8_SA(0, 1), a2 + hstepA, voffA);
            PG8_WAIT_V(8); PG8_WAIT_L(0); PG8_BAR; PG8_MMA(0, 0, At, B0); PG8_MMA(0, 1, At, B1); PG8_BAR; PG8_SCHED;
            PG8_LDA(At, 1, 1); PG8_STAGE(PG8_SB(1, 0), b3, voffB); PG8_STAGE(PG8_SB(1, 1), b3 + hstepB, voffB); PG8_STAGE(PG8_SA(1, 0), a3, voffA);
            PG8_WAIT_V(8); PG8_WAIT_L(0); PG8_BAR; PG8_MMA(1, 0, At, B0); PG8_MMA(1, 1, At, B1); PG8_BAR; PG8_SCHED;
            } else {
            PG8_LDB(B0, 0, 0); PG8_SCHED; PG8_LDA(At, 0, 0); PG8_STAGE(PG8_SA(1, 1), a1 + hstepA, voffA);
            PG8_WAIT_L(8); PG8_BAR; PG8_WAIT_L(0); PG8_MMA(0, 0, At, B0); PG8_BAR; PG8_SCHED;
            PG8_LDB(B1, 0, 1); PG8_STAGE(PG8_SB(0, 0), b2, voffB);
            PG8_BAR; PG8_WAIT_L(0); PG8_MMA(0, 1, At, B1); PG8_BAR;
            PG8_LDA(At, 0, 1); PG8_STAGE(PG8_SA(0, 0), a2, voffA);
            PG8_BAR; PG8_WAIT_L(0); PG8_MMA(1, 0, At, B0); PG8_BAR; PG8_SCHED;
            PG8_STAGE(PG8_SB(0, 1), b2 + hstepB, voffB);
            PG8_WAIT_V(6); PG8_BAR; PG8_MMA(1, 1, At, B1); PG8_BAR;
            PG8_LDB(B0, 1, 0); PG8_SCHED; PG8_LDA(At, 1, 0); PG8_STAGE(PG8_SA(0, 1), a2 + hstepA, voffA);
            PG8_WAIT_L(8); PG8_BAR; PG8_WAIT_L(0); PG8_MMA(0, 0, At, B0); PG8_BAR; PG8_SCHED;
            PG8_LDB(B1, 1, 1); PG8_STAGE(PG8_SB(1, 0), b3, voffB);
            PG8_BAR; PG8_WAIT_L(0); PG8_MMA(0, 1, At, B1); PG8_BAR;
            PG8_LDA(At, 1, 1); PG8_STAGE(PG8_SA(1, 0), a3, voffA);
            PG8_BAR; PG8_WAIT_L(0); PG8_MMA(1, 0, At, B0); PG8_BAR; PG8_SCHED;
            PG8_STAGE(PG8_SB(1, 1), b3 + hstepB, voffB);
            PG8_WAIT_V(6); PG8_BAR; PG8_MMA(1, 1, At, B1); PG8_BAR;
            }
        }
        if constexpr (ALIGN_EPI) { if (wr == 0) PG8_BAR; }
        E(acc, cur, wr, wc, fr, fq);
        if (!has_next) break;
#pragma unroll
        for (int a = 0; a < 2; ++a)
#pragma unroll
            for (int b = 0; b < 2; ++b)
#pragma unroll
                for (int m = 0; m < 4; ++m)
#pragma unroll
                    for (int n = 0; n < 2; ++n) acc[a][b][m][n] = (f32x4){0.f, 0.f, 0.f, 0.f};
        cur = nxt; cA = nA; cB = nB; ++ui;
        if constexpr (ALIGN_EPI) { if (wr == 1) PG8_BAR; }
    }
    PG8_WAIT_V(0);
    if constexpr (!ALIGN_EPI) { if (wr == 0) PG8_BAR; }
    PG8_BAR;
#undef PG8_SA
#undef PG8_SB
#undef PG8_STAGE
#undef PG8_LDA
#undef PG8_LDB
#undef PG8_MMA
#undef PG8_WAIT_V
#undef PG8_WAIT_L
#undef PG8_BAR
#undef PG8_SCHED
}
}

using pg8::Unit;
struct EpiIn {
    static constexpr bool PERM = true;
    unsigned char* ws;
    __device__ __forceinline__ void operator()(const f32x4 (&acc)[2][2][4][2], const Unit& u, int wr, int wc, int fr, int fq) const {
        const int pn = u.pn; int mode, ld = 1024, cb; size_t boff; bool bt = false;
        if (pn < 4)       { mode = 0; boff = WS_QB; cb = pn * 256; }
        else if (pn < 8)  { mode = 1; boff = WS_KB; cb = (pn - 4) * 256; bt = true; }
        else if (pn < 12) { mode = 1; boff = WS_VB; cb = (pn - 8) * 256; bt = true; }
        else if (pn < 16) { mode = 2; boff = WS_GA; cb = (pn - 12) * 256; }
        else if (pn < 20) { mode = 1; boff = WS_UB; cb = (pn - 16) * 256; bt = true; }
        else if (pn < 24) { mode = 2; boff = WS_GP; cb = (pn - 20) * 256; }
        else if (pn < 32) { mode = 3; boff = WS_SMA; cb = (pn - 24) * 256; ld = 2048; }
        else              { mode = 3; boff = WS_SMP; cb = (pn - 32) * 256; ld = 2048; }
        const int col0 = cb + wc * 32 + 8 * fq;
#pragma unroll
        for (int ai = 0; ai < 2; ++ai)
#pragma unroll
            for (int m = 0; m < 4; ++m) {
                const int row = u.pm * 256 + ai * 128 + wr * 64 + m * 16 + fr;
                {
                    const int drow = bt ? btrow(row) : row;
                    bf16_t* rowp = (bf16_t*)(ws + boff) + (size_t)drow * ld + col0;
#pragma unroll
                    for (int bj = 0; bj < 2; ++bj) {
                        f32x4 v0 = acc[ai][bj][m][0], v1 = acc[ai][bj][m][1];
                        if (mode == 0) { v0 = v0 * QSCALE; v1 = v1 * QSCALE; }
                        else if (mode == 2) {
#pragma unroll
                            for (int e = 0; e < 4; ++e) { v0[e] = v0[e] * fsigmoid(v0[e]); v1[e] = v1[e] * fsigmoid(v1[e]); }
                        } else if (mode == 3) {
#pragma unroll
                            for (int e = 0; e < 4; ++e) { v0[e] = fsigmoid(v0[e]); v1[e] = fsigmoid(v1[e]); }
                        }
                        u32x4 w; w.x = cvt_pk_bf16(v0[0], v0[1]); w.y = cvt_pk_bf16(v0[2], v0[3]); w.z = cvt_pk_bf16(v1[0], v1[1]); w.w = cvt_pk_bf16(v1[2], v1[3]);
                        *(u32x4*)(rowp + bj * 128) = w;
                    }
                }
                asm volatile("" ::: "memory");
            }
    }
};
struct EpiPool {
    static constexpr bool PERM = true;
    const float* scale; const bf16_t* GP; bf16_t* OAP; int g;
    __device__ __forceinline__ void operator()(const f32x4 (&acc)[2][2][4][2], const Unit& u, int wr, int wc, int fr, int fq) const {
        const int col0 = g * 256 + wc * 32 + 8 * fq;
#pragma unroll
        for (int ai = 0; ai < 2; ++ai)
#pragma unroll
            for (int m = 0; m < 4; ++m) {
                const int row = u.pm * 256 + ai * 128 + wr * 64 + m * 16 + fr;
                if (row < MROWS) {
#pragma unroll
                    for (int bj = 0; bj < 2; ++bj) {
                        const f32x4 s0 = *(const f32x4*)(scale + col0 + bj * 128), s1 = *(const f32x4*)(scale + col0 + bj * 128 + 4);
                        const u32x4 gw = *(const u32x4*)(GP + (size_t)row * 1024 + col0 + bj * 128);
                        const f32x4 a0 = acc[ai][bj][m][0], a1 = acc[ai][bj][m][1];
                        u32x4 w;
                        w.x = cvt_pk_bf16(a0[0] * s0[0] * bf_lo(gw.x), a0[1] * s0[1] * bf_hi(gw.x));
                        w.y = cvt_pk_bf16(a0[2] * s0[2] * bf_lo(gw.y), a0[3] * s0[3] * bf_hi(gw.y));
                        w.z = cvt_pk_bf16(a1[0] * s1[0] * bf_lo(gw.z), a1[1] * s1[1] * bf_hi(gw.z));
                        w.w = cvt_pk_bf16(a1[2] * s1[2] * bf_lo(gw.w), a1[3] * s1[3] * bf_hi(gw.w));
                        *(u32x4*)(OAP + (size_t)row * 2048 + 1024 + col0 + bj * 128) = w;
                    }
                }
                asm volatile("" ::: "memory");
            }
    }
};
struct EpiT1 {
    static constexpr bool PERM = true;
    const bf16_t* SMA; float* T1;
    __device__ __forceinline__ void operator()(const f32x4 (&acc)[2][2][4][2], const Unit& u, int wr, int wc, int fr, int fq) const {
        const int col0 = u.pn * 256 + wc * 32 + 8 * fq;
#pragma unroll
        for (int ai = 0; ai < 2; ++ai)
#pragma unroll
            for (int m = 0; m < 4; ++m) {
                const int row = u.pm * 256 + ai * 128 + wr * 64 + m * 16 + fr;
                {
#pragma unroll
                    for (int bj = 0; bj < 2; ++bj) {
                        const size_t off = (size_t)row * 2048 + col0 + bj * 128;
                        const u32x4 gw = *(const u32x4*)(SMA + off);
                        const f32x4 a0 = acc[ai][bj][m][0], a1 = acc[ai][bj][m][1];
                        f32x4 o0, o1;
                        o0[0] = a0[0] * bf_lo(gw.x); o0[1] = a0[1] * bf_hi(gw.x); o0[2] = a0[2] * bf_lo(gw.y); o0[3] = a0[3] * bf_hi(gw.y);
                        o1[0] = a1[0] * bf_lo(gw.z); o1[1] = a1[1] * bf_hi(gw.z); o1[2] = a1[2] * bf_lo(gw.w); o1[3] = a1[3] * bf_hi(gw.w);
                        *(f32x4*)(T1 + off) = o0; *(f32x4*)(T1 + off + 4) = o1;
                    }
                }
                asm volatile("" ::: "memory");
            }
    }
};
struct EpiMg {
    static constexpr bool PERM = true;
    const bf16_t* SMP; const float* T1; bf16_t* MG;
    __device__ __forceinline__ void operator()(const f32x4 (&acc)[2][2][4][2], const Unit& u, int wr, int wc, int fr, int fq) const {
        const int col0 = u.pn * 256 + wc * 32 + 8 * fq;
#pragma unroll
        for (int ai = 0; ai < 2; ++ai)
#pragma unroll
            for (int m = 0; m < 4; ++m) {
                const int row = u.pm * 256 + ai * 128 + wr * 64 + m * 16 + fr;
                {
#pragma unroll
                    for (int bj = 0; bj < 2; ++bj) {
                        const size_t off = (size_t)row * 2048 + col0 + bj * 128;
                        const u32x4 gw = *(const u32x4*)(SMP + off);
                        const f32x4 t0 = *(const f32x4*)(T1 + off), t1 = *(const f32x4*)(T1 + off + 4);
                        const f32x4 a0 = acc[ai][bj][m][0], a1 = acc[ai][bj][m][1];
                        u32x4 w;
                        w.x = cvt_pk_bf16(t0[0] + a0[0] * bf_lo(gw.x), t0[1] + a0[1] * bf_hi(gw.x));
                        w.y = cvt_pk_bf16(t0[2] + a0[2] * bf_lo(gw.y), t0[3] + a0[3] * bf_hi(gw.y));
                        w.z = cvt_pk_bf16(t1[0] + a1[0] * bf_lo(gw.z), t1[1] + a1[1] * bf_hi(gw.z));
                        w.w = cvt_pk_bf16(t1[2] + a1[2] * bf_lo(gw.w), t1[3] + a1[3] * bf_hi(gw.w));
                        *(u32x4*)(MG + off) = w;
                    }
                }
                asm volatile("" ::: "memory");
            }
    }
};
struct EpiRes {
    static constexpr bool PERM = true;
    float* XS;
    __device__ __forceinline__ void operator()(const f32x4 (&acc)[2][2][4][2], const Unit& u, int wr, int wc, int fr, int fq) const {
        const int col0 = u.pn * 256 + wc * 32 + 8 * fq;
#pragma unroll
        for (int ai = 0; ai < 2; ++ai)
#pragma unroll
            for (int m = 0; m < 4; ++m) {
                const int row = u.pm * 256 + ai * 128 + wr * 64 + m * 16 + fr;
                {
#pragma unroll
                    for (int bj = 0; bj < 2; ++bj) {
                        const size_t off = (size_t)row * 2048 + col0 + bj * 128;
                        const f32x4 t0 = *(const f32x4*)(XS + off), t1 = *(const f32x4*)(XS + off + 4);
                        *(f32x4*)(XS + off) = t0 + acc[ai][bj][m][0]; *(f32x4*)(XS + off + 4) = t1 + acc[ai][bj][m][1];
                    }
                }
                asm volatile("" ::: "memory");
            }
    }
};

struct Args {
    const float* x; const float* meta; const float* norm_gain; const float* w_in; const float* pool_w; const float* pool_scale;
    const float* w_attn_up; const float* w_pool_up; const float* w_out; const float* final_gain;
    float* out; unsigned char* ws; int ph_lo, ph_hi;
};

__device__ __forceinline__ void transpose_item(const float* W, int N, bf16_t* WT, int ldwt, int coff, LAS float* scr, int kb, int nb, int lane) {
    const int k0 = 64 * kb, n0 = 32 * nb;
    float tv[32];
#pragma unroll
    for (int i = 0; i < 32; ++i) { const int kk = 2 * i + (lane >> 5); tv[i] = W[(size_t)(k0 + kk) * N + n0 + (lane & 31)]; }
#pragma unroll
    for (int i = 0; i < 32; ++i) { const int kk = 2 * i + (lane >> 5); scr[kk * 33 + (lane & 31)] = tv[i]; }
    asm volatile("s_waitcnt lgkmcnt(0)" ::: "memory");
    const int c = lane & 7;
#pragma unroll
    for (int j = 0; j < 4; ++j) { const int n = (lane >> 3) + 8 * j; const LAS float* s = scr + (8 * c) * 33 + n;
        u32x4 o; o.x = cvt_pk_bf16(s[0 * 33], s[1 * 33]); o.y = cvt_pk_bf16(s[2 * 33], s[3 * 33]); o.z = cvt_pk_bf16(s[4 * 33], s[5 * 33]); o.w = cvt_pk_bf16(s[6 * 33], s[7 * 33]);
        *(u32x4*)(WT + (size_t)(n0 + n) * ldwt + coff + k0 + 8 * c) = o; }
    asm volatile("s_waitcnt lgkmcnt(0)" ::: "memory");
}
__device__ __forceinline__ void rms_row_bf16(const float* xrow, const float* gain, bf16_t* orow, float* xs_out, int lane) {
    const f32x4* xr = (const f32x4*)xrow + lane;
    f32x4 v[8]; float s = 0.f;
#pragma unroll
    for (int j = 0; j < 8; ++j) { v[j] = xr[64 * j]; s += (v[j][0] * v[j][0] + v[j][1] * v[j][1]) + (v[j][2] * v[j][2] + v[j][3] * v[j][3]); }
    const float r = 1.0f / sqrtf(wave_sum(s, lane) * (1.0f / DM) + RMS_EPS);
    if (xs_out) {
#pragma unroll
        for (int j = 0; j < 8; ++j) ((f32x4*)xs_out + lane)[64 * j] = v[j];
    }
    const f32x4* gr = (const f32x4*)gain + lane;
    u32x2* o8 = (u32x2*)orow + lane;
#pragma unroll
    for (int j = 0; j < 8; ++j) { const f32x4 g = gr[64 * j]; u32x2 w; w.x = cvt_pk_bf16(v[j][0] * r * g[0], v[j][1] * r * g[1]); w.y = cvt_pk_bf16(v[j][2] * r * g[2], v[j][3] * r * g[3]); o8[64 * j] = w; }
}
__device__ __forceinline__ void rms_row_f32(const float* xrow, const float* gain, float* orow, int lane) {
    const f32x4* xr = (const f32x4*)xrow + lane;
    f32x4 v[8]; float s = 0.f;
#pragma unroll
    for (int j = 0; j < 8; ++j) { v[j] = xr[64 * j]; s += (v[j][0] * v[j][0] + v[j][1] * v[j][1]) + (v[j][2] * v[j][2] + v[j][3] * v[j][3]); }
    const float r = 1.0f / sqrtf(wave_sum(s, lane) * (1.0f / DM) + RMS_EPS);
    const f32x4* gr = (const f32x4*)gain + lane;
#pragma unroll
    for (int j = 0; j < 8; ++j) { const f32x4 g = gr[64 * j]; ((f32x4*)orow + lane)[64 * j] = v[j] * r * g; }
}

constexpr int KS = 272;
constexpr int TILEB = 64 * KS;
__device__ __forceinline__ float fexp2(float x) { return __builtin_amdgcn_exp2f(x); }
__device__ __forceinline__ float frcp(float x) { return __builtin_amdgcn_rcpf(x); }

__device__ __forceinline__ void attn_unit(LAS unsigned char* lds, const bf16_t* __restrict__ QB, const bf16_t* __restrict__ KB, const bf16_t* __restrict__ VB,
                                          const bf16_t* __restrict__ GA, bf16_t* __restrict__ OAP, int b, int h, int qb) {
    const int tid = tid_fresh(), w = __builtin_amdgcn_readfirstlane(tid >> 6), l = tid & 63, qi = l & 15, lg = l >> 4;
    const int tq0 = 64 + 128 * qb + 16 * w;
    const bool wactive = (tq0 >= TOFF);
    const int tq = tq0 + qi;
    const int mrow = (tq0 >= 64) ? (b * 2048 + tq - 64) : (MREAL + (wactive ? tq - TOFF : 0));
    const int jtop = (qb >= 0) ? 2 * qb + 2 : 0, ntiles = jtop + 1;
    const int jw = wactive ? ((tq0 + 14) >> 6) : -1;
    bf16x8 qf[4];
#pragma unroll
    for (int dc = 0; dc < 4; ++dc) qf[dc] = *(const bf16x8*)(QB + (size_t)mrow * 1024 + h * 128 + dc * 32 + lg * 8);
    f32x4 o[8];
#pragma unroll
    for (int dg = 0; dg < 8; ++dg) o[dg] = (f32x4){0.f, 0.f, 0.f, 0.f};
    float P = 1.0f;
    const size_t gbase = ((size_t)b * LP) * 1024 + h * 128;
    u32x4 kreg[2], vreg[2];
    auto gload = [&](int j) {
#pragma unroll
        for (int i = 0; i < 2; ++i) { const int p = tid + 512 * i, r = p >> 4, c = p & 15; const size_t off = gbase + (size_t)(64 * j + r) * 1024 + c * 8;
            kreg[i] = *(const u32x4*)(KB + off); vreg[i] = *(const u32x4*)(VB + off); }
    };
    auto lwrite = [&](int buf) {
#pragma unroll
        for (int i = 0; i < 2; ++i) { const int p = tid + 512 * i, r = p >> 4, c = p & 15;
            *(LAS u32x4*)(lds + buf * 2 * TILEB + r * KS + c * 16) = kreg[i]; *(LAS u32x4*)(lds + buf * 2 * TILEB + TILEB + r * KS + c * 16) = vreg[i]; }
    };
    LAS volatile int* flags = (LAS volatile int*)(lds + MISC_OFF + 64);
    gload(jtop); lwrite(0);
    __syncthreads();
    const int kbase = (16 * (qi >> 2) + (qi & 3)) * KS + lg * 16;
    const int vbase = (16 * lg + (qi >> 2)) * KS + (qi & 3) * 8;
    for (int it = 0; it < ntiles; ++it) {
        const int j = jtop - it, cur = it & 1;
        if (it + 1 < ntiles) gload(j - 1);
        if (j <= jw) {
            LAS unsigned char* Kb = lds + cur * 2 * TILEB; LAS unsigned char* Vb = Kb + TILEB;
            f32x4 s[4];
            float zf = 0.f; asm volatile("" : "+v"(zf));
#pragma unroll
            for (int g = 0; g < 4; ++g) s[g] = (f32x4){zf, zf, zf, zf};
#pragma unroll
            for (int dc = 0; dc < 4; ++dc)
#pragma unroll
                for (int g = 0; g < 4; ++g) { const bf16x8 kf = *(const LAS bf16x8*)(Kb + kbase + g * 4 * KS + dc * 64); s[g] = __builtin_amdgcn_mfma_f32_16x16x32_bf16(kf, qf[dc], s[g], 0, 0, 0); }
            const bool need_mask = (64 * j + 63 >= tq0) || (j == 0);
            float beta[16], omb[16];
#pragma unroll
            for (int kk = 0; kk < 16; ++kk) {
                const float z = fmaxf(s[kk >> 2][kk & 3], -60.0f);
                const float t = fexp2(-z), r = frcp(1.0f + t);
                beta[kk] = r; omb[kk] = t * r;
            }
            if (need_mask) {
                const int tk0 = 64 * j + 16 * lg;
#pragma unroll
                for (int kk = 0; kk < 16; ++kk) { const int tk = tk0 + kk; const bool valid = (tk >= TOFF) && (tk < tq); beta[kk] = valid ? beta[kk] : 0.0f; omb[kk] = valid ? omb[kk] : 1.0f; }
            }
            float e[16]; e[15] = 1.0f;
#pragma unroll
            for (int kk = 14; kk >= 0; --kk) e[kk] = e[kk + 1] * omb[kk + 1];
            const float T = e[0] * omb[0];
            const float T1 = shfl_idx(T, (l + 16) & 63), T2 = shfl_idx(T, (l + 32) & 63), T3 = shfl_idx(T, (l + 48) & 63);
            float G = 1.0f;
            if (lg <= 2) G *= T1;
            if (lg <= 1) G *= T2;
            if (lg == 0) G *= T3;
            const float c = P * G;
            P = P * ((T * T1) * (T2 * T3));
            float a[16];
#pragma unroll
            for (int kk = 0; kk < 16; ++kk) a[kk] = beta[kk] * (e[kk] * c);
            bf16x8 pa[2];
#pragma unroll
            for (int mm = 0; mm < 2; ++mm) {
                u32x4 wv; wv.x = cvt_pk_bf16(a[8 * mm + 0], a[8 * mm + 1]); wv.y = cvt_pk_bf16(a[8 * mm + 2], a[8 * mm + 3]); wv.z = cvt_pk_bf16(a[8 * mm + 4], a[8 * mm + 5]); wv.w = cvt_pk_bf16(a[8 * mm + 6], a[8 * mm + 7]);
                pa[mm] = __builtin_bit_cast(bf16x8, wv);
            }
#pragma unroll
            for (int dg = 0; dg < 8; ++dg)
#pragma unroll
                for (int mm = 0; mm < 2; ++mm) {
                    const s16x4 v0 = __builtin_bit_cast(s16x4, __builtin_amdgcn_ds_read_tr16_b64_v4i16((LAS s16x4*)(Vb + vbase + (8 * mm) * KS + dg * 32)));
                    const s16x4 v1 = __builtin_bit_cast(s16x4, __builtin_amdgcn_ds_read_tr16_b64_v4i16((LAS s16x4*)(Vb + vbase + (8 * mm + 4) * KS + dg * 32)));
                    bf16x8 vf; vf[0] = v0[0]; vf[1] = v0[1]; vf[2] = v0[2]; vf[3] = v0[3]; vf[4] = v1[0]; vf[5] = v1[1]; vf[6] = v1[2]; vf[7] = v1[3];
                    o[dg] = __builtin_amdgcn_mfma_f32_16x16x32_bf16(vf, pa[mm], o[dg], 0, 0, 0);
                }
        }
        if (it + 1 < ntiles) lwrite(cur ^ 1);
        { const bool wdone = !wactive || (j <= jw && __builtin_amdgcn_ballot_w64(P != 0.0f) == 0ull);
          if (l == 0) flags[(it & 1) * 8 + w] = wdone ? 1 : 0; }
        __syncthreads();
        { int alld = 1;
#pragma unroll
          for (int ww = 0; ww < 8; ++ww) alld &= flags[(it & 1) * 8 + ww];
          if (alld) break; }
    }
    if (wactive) {
#pragma unroll
        for (int dg = 0; dg < 8; ++dg) {
            const size_t col = (size_t)h * 128 + 16 * dg + 4 * lg;
            const u32x2 gw = *(const u32x2*)(GA + (size_t)mrow * 1024 + col);
            u32x2 wv; wv.x = cvt_pk_bf16(o[dg][0] * bf_lo(gw.x), o[dg][1] * bf_hi(gw.x)); wv.y = cvt_pk_bf16(o[dg][2] * bf_lo(gw.y), o[dg][3] * bf_hi(gw.y));
            *(u32x2*)(OAP + (size_t)mrow * 2048 + col) = wv;
        }
    }
}

__device__ __forceinline__ void load8f(const bf16_t* p, float (&f)[8]) {
    const u32x4 w = *(const u32x4*)p;
    f[0] = bf_lo(w.x); f[1] = bf_hi(w.x); f[2] = bf_lo(w.y); f[3] = bf_hi(w.y); f[4] = bf_lo(w.z); f[5] = bf_hi(w.z); f[6] = bf_lo(w.w); f[7] = bf_hi(w.w);
}
__device__ __forceinline__ void pool_unit(LAS unsigned char* lds, const bf16_t* __restrict__ UB, bf16_t* __restrict__ PL, const bf16_t* PWT  , const float* scale  ,
                                          const bf16_t* GP, bf16_t* OAP, int pm, int g) {
    const int tid = tid_fresh(), cc = tid & 31, strip = tid >> 5;
    const int w = 2 << g;
    int b, tb, m0; bool valid = true;
    if (pm < 32) { const int r0 = pm * 256 + strip * 16; b = r0 >> 11; tb = 64 + (r0 & 2047); m0 = r0; }
    else { b = 0; tb = TOFF; m0 = MREAL; valid = strip == 0; }
    if (valid) {
        const bf16_t* up = UB + ((size_t)(b * LP + tb)) * 1024 + g * 256 + cc * 8;
        float S[8];
#pragma unroll
        for (int e = 0; e < 8; ++e) S[e] = 0.f;
        for (int j = 1; j < w; ++j) { float f[8]; load8f(up - (size_t)j * 1024, f);
#pragma unroll
            for (int e = 0; e < 8; ++e) S[e] += f[e]; }
        for (int rr = 0; rr < 16; ++rr) {
            float cu[8]; load8f(up + (size_t)rr * 1024, cu);
            if (rr > 0) { float f[8]; load8f(up + (size_t)(rr - w) * 1024, f);
#pragma unroll
                for (int e = 0; e < 8; ++e) S[e] -= f[e]; }
#pragma unroll
            for (int e = 0; e < 8; ++e) S[e] += cu[e];
            const int t = tb + rr - TOFF; const float inv = 1.0f / (float)((t + 1) < w ? (t + 1) : w);
            u32x4 o; o.x = cvt_pk_bf16(S[0] * inv - cu[0], S[1] * inv - cu[1]); o.y = cvt_pk_bf16(S[2] * inv - cu[2], S[3] * inv - cu[3]);
            o.z = cvt_pk_bf16(S[4] * inv - cu[4], S[5] * inv - cu[5]); o.w = cvt_pk_bf16(S[6] * inv - cu[6], S[7] * inv - cu[7]);
            *(u32x4*)(PL + (size_t)(m0 + rr) * 1024 + g * 256 + cc * 8) = o;
        }
    }
    __threadfence();
    __syncthreads();
    pg8::Gemm gm{PL + g * 256, PWT + (size_t)g * GD * GD};
    pg8::OneUnit S1{{pm, 0}};
    EpiPool E{scale, GP, OAP, g};
    pg8::gemm_phase<EpiPool, pg8::OneUnit, 1024, 256, 256>(lds, gm, S1, E);
}

template <int KLEN>
__device__ __forceinline__ f32x4 skinny_acc(const bf16_t* __restrict__ wp  , const bf16_t* __restrict__ hp  , f32x4 acc) {
#pragma unroll 1
    for (int k0 = 0; k0 < KLEN; k0 += 256) {
        bf16x8 wv[8], hv[8];
#pragma unroll
        for (int u = 0; u < 8; ++u) { wv[u] = *(const bf16x8*)(wp + k0 + 32 * u); hv[u] = *(const bf16x8*)(hp + k0 + 32 * u); }
#pragma unroll
        for (int u = 0; u < 8; ++u) acc = __builtin_amdgcn_mfma_f32_16x16x32_bf16(wv[u], hv[u], acc, 0, 0, 0);
    }
    return acc;
}
__device__ __forceinline__ void skinny_in(unsigned char* ws, const bf16_t* WINL, int gw, int NGW, int lane) {
    const bf16_t* HB = (const bf16_t*)(ws + WS_HB);
    const int t = lane & 15, g4 = lane >> 4;
    for (int nt = gw; nt < INC / 16; nt += NGW) {
        const int n0 = nt * 16;
        f32x4 v = skinny_acc<DM>(WINL + (size_t)(n0 + t) * DM + g4 * 8, HB + (size_t)(MREAL + t) * DM + g4 * 8, (f32x4){0.f, 0.f, 0.f, 0.f});
        const int c = n0 + 4 * g4;
        int mode, ld = 1024, cb; size_t boff; bool bt = false;
        if (c < 1024)      { mode = 0; boff = WS_QB; cb = c; }
        else if (c < 2048) { mode = 1; boff = WS_KB; cb = c - 1024; bt = true; }
        else if (c < 3072) { mode = 1; boff = WS_VB; cb = c - 2048; bt = true; }
        else if (c < 4096) { mode = 2; boff = WS_GA; cb = c - 3072; }
        else if (c < 5120) { mode = 1; boff = WS_UB; cb = c - 4096; bt = true; }
        else if (c < 6144) { mode = 2; boff = WS_GP; cb = c - 5120; }
        else if (c < 8192) { mode = 3; boff = WS_SMA; cb = c - 6144; ld = 2048; }
        else               { mode = 3; boff = WS_SMP; cb = c - 8192; ld = 2048; }
        if (mode == 0) v = v * QSCALE;
        else if (mode == 2) { for (int e = 0; e < 4; ++e) v[e] = v[e] * fsigmoid(v[e]); }
        else if (mode == 3) { for (int e = 0; e < 4; ++e) v[e] = fsigmoid(v[e]); }
        u32x2 w; w.x = cvt_pk_bf16(v[0], v[1]); w.y = cvt_pk_bf16(v[2], v[3]);
        bf16_t* base = (bf16_t*)(ws + boff);
        if (bt) {
#pragma unroll
            for (int b = 0; b < NB; ++b) *(u32x2*)(base + (size_t)(b * LP + TOFF + t) * 1024 + cb) = w;
        } else *(u32x2*)(base + (size_t)(MREAL + t) * ld + cb) = w;
    }
}
__device__ __forceinline__ void skinny_merge(unsigned char* ws, const bf16_t* WML, int gw, int NGW, int lane) {
    const bf16_t* OAP = (const bf16_t*)(ws + WS_OAP); const bf16_t* SMA = (const bf16_t*)(ws + WS_SMA); const bf16_t* SMP = (const bf16_t*)(ws + WS_SMP); bf16_t* MG = (bf16_t*)(ws + WS_MG);
    const int t = lane & 15, g4 = lane >> 4;
    for (int nt = gw; nt < DM / 16; nt += NGW) {
        const int n0 = nt * 16;
        const f32x4 z = (f32x4){0.f, 0.f, 0.f, 0.f};
        const f32x4 y1 = skinny_acc<1024>(WML + (size_t)(n0 + t) * DM + g4 * 8, OAP + (size_t)(MREAL + t) * DM + g4 * 8, z);
        const f32x4 y2 = skinny_acc<1024>(WML + (size_t)(n0 + t) * DM + 1024 + g4 * 8, OAP + (size_t)(MREAL + t) * DM + 1024 + g4 * 8, z);
        const size_t off = (size_t)(MREAL + t) * DM + n0 + 4 * g4;
        const u32x2 ga = *(const u32x2*)(SMA + off), gp = *(const u32x2*)(SMP + off);
        u32x2 w;
        w.x = cvt_pk_bf16(y1[0] * bf_lo(ga.x) + y2[0] * bf_lo(gp.x), y1[1] * bf_hi(ga.x) + y2[1] * bf_hi(gp.x));
        w.y = cvt_pk_bf16(y1[2] * bf_lo(ga.y) + y2[2] * bf_lo(gp.y), y1[3] * bf_hi(ga.y) + y2[3] * bf_hi(gp.y));
        *(u32x2*)(MG + off) = w;
    }
}
__device__ __forceinline__ void skinny_out(unsigned char* ws, const bf16_t* WOL, int gw, int NGW, int lane) {
    const bf16_t* MG = (const bf16_t*)(ws + WS_MG); float* XS = (float*)(ws + WS_XS);
    const int t = lane & 15, g4 = lane >> 4;
    for (int nt = gw; nt < DM / 16; nt += NGW) {
        const int n0 = nt * 16;
        const f32x4 y = skinny_acc<DM>(WOL + (size_t)(n0 + t) * DM + g4 * 8, MG + (size_t)(MREAL + t) * DM + g4 * 8, (f32x4){0.f, 0.f, 0.f, 0.f});
        f32x4* xp = (f32x4*)(XS + (size_t)(MREAL + t) * DM + n0 + 4 * g4);
        *xp = *xp + y;
    }
}

constexpr int PH_PRO = 0, PH_FINAL = 1 + 5 * DEPTH, N_PHASES = PH_FINAL + 1;
constexpr int N_ATT = 32 * 16, N_POOLU = 33 * 4, N_METAU = 8, N_BITEMS = N_ATT + N_POOLU + N_METAU;

__device__ __forceinline__ void grid_bar(unsigned* cnt, unsigned target) {
    asm volatile("s_waitcnt vmcnt(0)" ::: "memory");
    __syncthreads();
    if (tid_fresh() == 0) {
        __builtin_amdgcn_fence(__ATOMIC_RELEASE, "agent");
        asm volatile("s_waitcnt vmcnt(0)" ::: "memory");
        __hip_atomic_fetch_add(cnt, 1u, __ATOMIC_RELAXED, __HIP_MEMORY_SCOPE_AGENT);
        while (__hip_atomic_load(cnt, __ATOMIC_RELAXED, __HIP_MEMORY_SCOPE_AGENT) < target) __builtin_amdgcn_s_sleep(1);
        __builtin_amdgcn_fence(__ATOMIC_ACQUIRE, "agent");
        asm volatile("s_waitcnt vmcnt(0)" ::: "memory");
    }
    __syncthreads();
}

#define TID_VARS() const int tid = tid_fresh(), lane = tid & 63, wave = __builtin_amdgcn_readfirstlane(tid >> 6); const int gw = bx * 8 + wave, NGW = G * 8; (void)lane; (void)gw; (void)NGW; (void)tid;
#define WS_PTRS() \
    unsigned char* ws = args.ws; asm volatile("" : "+s"(ws)); \
    unsigned* ctl = (unsigned*)(ws + WS_CTL); (void)ctl; \
    float* XS = (float*)(ws + WS_XS); bf16_t* HB = (bf16_t*)(ws + WS_HB); (void)XS; (void)HB; \
    bf16_t* WIN = (bf16_t*)(ws + WS_WIN); bf16_t* WM = (bf16_t*)(ws + WS_WM); bf16_t* WO = (bf16_t*)(ws + WS_WO); bf16_t* PWT = (bf16_t*)(ws + WS_PW); (void)WIN; (void)WM; (void)WO; (void)PWT; \
    bf16_t* QB = (bf16_t*)(ws + WS_QB); bf16_t* KB = (bf16_t*)(ws + WS_KB); bf16_t* VB = (bf16_t*)(ws + WS_VB); bf16_t* UB = (bf16_t*)(ws + WS_UB); (void)QB; (void)KB; (void)VB; (void)UB; \
    bf16_t* GA = (bf16_t*)(ws + WS_GA); bf16_t* GP = (bf16_t*)(ws + WS_GP); bf16_t* SMA = (bf16_t*)(ws + WS_SMA); bf16_t* SMP = (bf16_t*)(ws + WS_SMP); (void)GA; (void)GP; (void)SMA; (void)SMP; \
    bf16_t* OAP = (bf16_t*)(ws + WS_OAP); bf16_t* PL = (bf16_t*)(ws + WS_PL); float* T1 = (float*)(ws + WS_T1); bf16_t* MG = (bf16_t*)(ws + WS_MG); (void)OAP; (void)PL; (void)T1; (void)MG;
#define IN(k) (lo <= (k) && (k) < hi)
#if MK_MULTI
#define SEAM(k) do { } while (0)
#else
#define SEAM(k) do { if (IN(k) && IN((k) + 1)) { unsigned char* wsb = args.ws; asm volatile("" : "+s"(wsb)); ++nbar; grid_bar((unsigned*)(wsb + WS_CTL) + 128, nbar * (unsigned)G); } } while (0)
#endif

template <int L>
__device__ __forceinline__ void layer_phases(const Args& args, LAS unsigned char* lds, const int G, const int bx, const int lo, const int hi, unsigned& nbar) {
    constexpr int P0 = 1 + 5 * L;
    if (L > 0 && IN(P0)) {
        WS_PTRS(); TID_VARS();
#ifdef REP_N
        for (int m = gw; m < MROWS; m += NGW) rms_row_bf16(XS + (size_t)m * DM, args.norm_gain + (size_t)L * DM, HB + (size_t)m * DM, nullptr, lane);
#endif
        for (int m = gw; m < MROWS; m += NGW) rms_row_bf16(XS + (size_t)m * DM, args.norm_gain + (size_t)L * DM, HB + (size_t)m * DM, nullptr, lane);
    }
    SEAM(P0);
    if (IN(P0 + 1)) {
        WS_PTRS();
#ifndef DIS_A
        for (int rep = 0; rep < REP_A; ++rep) {
        pg8::Gemm g{HB, WIN + (size_t)L * INC * DM}; pg8::StaticOrder S; S.init(MREAL, INC, G, bx);
        EpiIn E{ws};
        pg8::gemm_phase<EpiIn, pg8::StaticOrder, DM, DM, DM>(lds, g, S, E);
        }
#endif
        { TID_VARS(); skinny_in(ws, WIN + (size_t)L * INC * DM, wave * G + bx, NGW, lane); }
    }
    SEAM(P0 + 1);
    if (IN(P0 + 2)) {
        WS_PTRS();
        LAS volatile int* item_s = (LAS volatile int*)(lds + MISC_OFF);
        for (int rep = 0; rep < REP_B; ++rep)
        for (;;) {
            __syncthreads();
            if (tid_fresh() == 0) *item_s = (int)atomicAdd(ctl + L + 8 * rep, 1u);
            __syncthreads();
            const int item = __builtin_amdgcn_readfirstlane(*item_s);
            if (item >= N_BITEMS) break;
#ifndef DIS_B
            if (item >= N_POOLU) {
                const int ia = item - N_POOLU;
                const int qb = ia < N_ATT ? 15 - ia / 32 : -1, bh = ia < N_ATT ? ia % 32 : ia - N_ATT;
                attn_unit(lds, QB, KB, VB, GA, OAP, bh >> 3, bh & 7, qb);
            } else {
                pool_unit(lds, UB, PL, PWT + (size_t)L * 4 * GD * GD, args.pool_scale + (size_t)L * PWD, GP, OAP, item >> 2, item & 3);
            }
#endif
        }
    }
    SEAM(P0 + 2);
    if (IN(P0 + 3)) {
        WS_PTRS();
        pg8::StaticOrder S; S.init(MREAL, DM, G, bx);
#ifndef DIS_C
        for (int rep = 0; rep < REP_C; ++rep) {
        { pg8::Gemm g{OAP, WM + (size_t)L * DM * DM}; EpiT1 E{SMA, T1}; pg8::gemm_phase<EpiT1, pg8::StaticOrder, DM, DM, 1024>(lds, g, S, E); }
        { pg8::Gemm g{OAP + 1024, WM + (size_t)L * DM * DM + 1024}; EpiMg E{SMP, T1, MG}; pg8::gemm_phase<EpiMg, pg8::StaticOrder, DM, DM, 1024>(lds, g, S, E); }
        }
#endif
        { TID_VARS(); skinny_merge(ws, WM + (size_t)L * DM * DM, wave * G + bx, NGW, lane); }
    }
    SEAM(P0 + 3);
    if (IN(P0 + 4)) {
        WS_PTRS();
#ifndef DIS_D
        pg8::Gemm g{MG, WO + (size_t)L * DM * DM}; pg8::StaticOrder S; S.init(MREAL, DM, G, bx);
#ifdef REP_D
        { EpiRes E0{T1}; pg8::gemm_phase<EpiRes, pg8::StaticOrder, DM, DM, DM>(lds, g, S, E0); }
#endif
        EpiRes E{XS};
        pg8::gemm_phase<EpiRes, pg8::StaticOrder, DM, DM, DM>(lds, g, S, E);
#endif
        { TID_VARS(); skinny_out(ws, WO + (size_t)L * DM * DM, wave * G + bx, NGW, lane); }
    }
    SEAM(P0 + 4);
}

__global__ void __launch_bounds__(512, 2) mega_fwd(Args args) {
    extern __shared__ __attribute__((aligned(16))) unsigned char lds_raw[];
    LAS unsigned char* lds = (LAS unsigned char*)lds_raw;
    cg::grid_group grid = cg::this_grid();
    const int G = gridDim.x, bx = blockIdx.x;
    const int lo = args.ph_lo, hi = args.ph_hi;
    if (hi < 0) grid.sync();
    unsigned nbar = 0;
    if (IN(PH_PRO)) {
        WS_PTRS(); TID_VARS();
#ifndef DIS_PRO
        for (int rep = 0; rep < REP_PRO; ++rep) {
        LAS float* scr = (LAS float*)(lds + wave * 8704);
        constexpr int I_IN = 32 * 320, I_UP = 16 * 64, I_OUT = 32 * 64, I_PW = 4 * 8;
        constexpr int PER_L = I_IN + 2 * I_UP + I_OUT + 4 * I_PW;
        for (int it = gw; it < DEPTH * PER_L; it += NGW) {
            const int L = it / PER_L; int r = it % PER_L;
            if (r < I_IN) { transpose_item(args.w_in + (size_t)L * DM * INC, INC, WIN + (size_t)L * INC * DM, DM, 0, scr, r / 320, r % 320, lane); continue; } r -= I_IN;
            if (r < I_UP) { transpose_item(args.w_attn_up + (size_t)L * SBW * DM, DM, WM + (size_t)L * DM * DM, DM, 0, scr, r / 64, r % 64, lane); continue; } r -= I_UP;
            if (r < I_UP) { transpose_item(args.w_pool_up + (size_t)L * PWD * DM, DM, WM + (size_t)L * DM * DM, DM, 1024, scr, r / 64, r % 64, lane); continue; } r -= I_UP;
            if (r < I_OUT) { transpose_item(args.w_out + (size_t)L * DM * DM, DM, WO + (size_t)L * DM * DM, DM, 0, scr, r / 64, r % 64, lane); continue; } r -= I_OUT;
            { const int gq = r / I_PW, rr = r % I_PW; transpose_item(args.pool_w + ((size_t)L * 4 + gq) * GD * GD, GD, PWT + ((size_t)L * 4 + gq) * GD * GD, GD, 0, scr, rr / 8, rr % 8, lane); }
        }
        }
#endif
        for (int m = gw; m < MROWS; m += NGW) {
            const float* src = (m < MREAL) ? args.x + (size_t)m * DM : args.meta + (size_t)(m - MREAL) * DM;
            rms_row_bf16(src, args.norm_gain, HB + (size_t)m * DM, XS + (size_t)m * DM, lane);
        }
        { unsigned zu = 0u; asm volatile("" : "+v"(zu)); const int gt = bx * 512 + tid, NGT = G * 512; constexpr int PIECES = NB * TOFF * 128;
          for (int p = gt; p < 3 * PIECES; p += NGT) { const int bufi = p / PIECES, q = p % PIECES, bb = q / (TOFF * 128), rem = q % (TOFF * 128);
              bf16_t* base = bufi == 0 ? KB : (bufi == 1 ? VB : UB);
              *(u32x4*)(base + (size_t)bb * LP * 1024 + (size_t)rem * 8) = (u32x4){zu, zu, zu, zu}; } }
    }
    SEAM(PH_PRO);
    layer_phases<0>(args, lds, G, bx, lo, hi, nbar);
    layer_phases<1>(args, lds, G, bx, lo, hi, nbar);
    layer_phases<2>(args, lds, G, bx, lo, hi, nbar);
    layer_phases<3>(args, lds, G, bx, lo, hi, nbar);
    if (IN(PH_FINAL)) {
        WS_PTRS(); TID_VARS();
        for (int m = gw; m < MREAL; m += NGW) rms_row_f32(XS + (size_t)m * DM, args.final_gain, args.out + (size_t)m * DM, lane);
    }
}

extern "C" void kernel_launch(void* const* d_in, const int* in_sizes, int n_in, void* d_out, int out_size, void* d_ws, size_t ws_size, hipStream_t stream) {
    static int grid = 0;
    if (grid == 0) {
        if (n_in != 10 || ws_size < WS_END) { fprintf(stderr, "kernel_launch: need 10 inputs and >= %zu bytes of workspace (got %d, %zu)\n", (size_t)WS_END, n_in, ws_size); grid = -1; return; }
        int dev = 0, cus = 0, per_cu = 0;
        hipGetDevice(&dev); hipDeviceGetAttribute(&cus, hipDeviceAttributeMultiprocessorCount, dev);
        if (hipFuncSetAttribute((const void*)mega_fwd, hipFuncAttributeMaxDynamicSharedMemorySize, LDS_BYTES) != hipSuccess) { fprintf(stderr, "kernel_launch: hipFuncSetAttribute failed\n"); grid = -1; return; }
        if (hipOccupancyMaxActiveBlocksPerMultiprocessor(&per_cu, (const void*)mega_fwd, 512, LDS_BYTES) != hipSuccess || per_cu < 1) { fprintf(stderr, "kernel_launch: occupancy query gave %d\n", per_cu); per_cu = 1; }
        (void)hipGetLastError();
        grid = cus * per_cu;
    }
    if (grid < 0) return;
    if (hipMemsetAsync((char*)d_ws + WS_CTL, 0, 4096, stream) != hipSuccess) { fprintf(stderr, "kernel_launch: memset failed\n"); return; }
    Args a{};
    a.x = (const float*)d_in[0]; a.meta = (const float*)d_in[1]; a.norm_gain = (const float*)d_in[2]; a.w_in = (const float*)d_in[3]; a.pool_w = (const float*)d_in[4];
    a.pool_scale = (const float*)d_in[5]; a.w_attn_up = (const float*)d_in[6]; a.w_pool_up = (const float*)d_in[7]; a.w_out = (const float*)d_in[8]; a.final_gain = (const float*)d_in[9];
    a.out = (float*)d_out; a.ws = (unsigned char*)d_ws;
#if MK_MULTI
    for (int ph = 0; ph < N_PHASES; ++ph) {
        if (ph >= 1 && ph < PH_FINAL && (ph - 1) % 5 == 0 && (ph - 1) / 5 == 0) continue;
        a.ph_lo = ph; a.ph_hi = ph + 1;
        hipLaunchKernelGGL(mega_fwd, dim3(grid), dim3(512), LDS_BYTES, stream, a);
    }
#else
    a.ph_lo = 0; a.ph_hi = N_PHASES;
    void* kargs[] = {&a};
    hipError_t e = hipLaunchCooperativeKernel((const void*)mega_fwd, dim3(grid), dim3(512), kargs, LDS_BYTES, stream);
    if (e != hipSuccess) fprintf(stderr, "cooperative launch failed: %s (grid %d)\n", hipGetErrorString(e), grid);
#endif
}
```

```cpp
#include <hip/hip_runtime.h>
#include <hip/hip_cooperative_groups.h>
#include <cstdio>
#include <cstdint>
namespace cg = cooperative_groups;

#ifndef REP_PRO
#define REP_PRO 1
#endif
#ifndef REP_A
#define REP_A 1
#endif
#ifndef REP_B
#define REP_B 1
#endif
#ifndef REP_C
#define REP_C 1
#endif
#ifndef MK_MULTI
#define MK_MULTI 0
#endif

#define LAS __attribute__((address_space(3)))
typedef unsigned short bf16_t;
typedef short bf16x8 __attribute__((ext_vector_type(8)));
typedef short s16x4 __attribute__((ext_vector_type(4)));
typedef float f32x4 __attribute__((ext_vector_type(4)));
typedef unsigned u32x4 __attribute__((ext_vector_type(4)));
typedef unsigned u32x2 __attribute__((ext_vector_type(2)));

constexpr int DM = 2048, NB = 4, SEQ = 2048, DEPTH = 4, NMETA = 16, NH = 8, DH = 128, SBW = 1024, PWD = 1024, GD = 256, INC = 10240;
constexpr int MREAL = NB * SEQ;
constexpr int MROWS = MREAL + NMETA;
constexpr int MPAD = 8448;
constexpr int LP = 2176;
constexpr int TOFF = 48;
constexpr float RMS_EPS = 1e-6f;
constexpr float LOG2E = 1.4426950408889634f;
constexpr float QSCALE = 0.08838834764831845f * LOG2E;

constexpr size_t al256(size_t x) { return (x + 255) & ~(size_t)255; }
constexpr size_t WS_CTL = 0;
constexpr size_t WS_SSQ = 4096;
constexpr int SSQ_STRIDE = 1;
constexpr size_t WS_BAR = WS_SSQ + (size_t)(DEPTH + 1) * MPAD * SSQ_STRIDE * 4;
constexpr size_t WS_ZERO_BYTES = WS_BAR + 16384;
constexpr size_t WS_XS = al256(WS_ZERO_BYTES);
constexpr size_t WS_HB = al256(WS_XS + (size_t)MPAD * DM * 4);
constexpr size_t WS_WIN = al256(WS_HB + (size_t)MPAD * DM * 2);
constexpr size_t WS_WM = al256(WS_WIN + (size_t)DEPTH * INC * DM * 2);
constexpr size_t WS_WO = al256(WS_WM + (size_t)DEPTH * DM * DM * 2);
constexpr size_t WS_PW = al256(WS_WO + (size_t)DEPTH * DM * DM * 2);
constexpr size_t WS_QB = al256(WS_PW + (size_t)DEPTH * 4 * GD * GD * 2);
constexpr size_t WS_KB = al256(WS_QB + (size_t)MPAD * 1024 * 2);
constexpr size_t WS_VB = al256(WS_KB + (size_t)NB * LP * 1024 * 2);
constexpr size_t WS_UB = al256(WS_VB + (size_t)NB * LP * 1024 * 2);
constexpr size_t WS_GA = al256(WS_UB + (size_t)NB * LP * 1024 * 2);
constexpr size_t WS_GP = al256(WS_GA + (size_t)MPAD * 1024 * 2);
constexpr size_t WS_SMA = al256(WS_GP + (size_t)MPAD * 1024 * 2);
constexpr size_t WS_SMP = al256(WS_SMA + (size_t)MPAD * DM * 2);
constexpr size_t WS_OAP = al256(WS_SMP + (size_t)MPAD * DM * 2);
constexpr size_t WS_PL = al256(WS_OAP + (size_t)MPAD * DM * 2);
constexpr size_t WS_T1 = al256(WS_PL + (size_t)MPAD * 1024 * 2);
constexpr size_t WS_MG = al256(WS_T1 + (size_t)MPAD * DM * 4);
constexpr size_t WS_END = al256(WS_MG + (size_t)MPAD * DM * 2);

constexpr int LDS_BYTES = 147456;
constexpr int RING_BYTES = 131072;
constexpr int MISC_OFF = RING_BYTES;

__device__ __forceinline__ unsigned cvt_pk_bf16(float lo, float hi) { unsigned r; asm volatile("v_cvt_pk_bf16_f32 %0, %1, %2" : "=v"(r) : "v"(lo), "v"(hi)); return r; }
__device__ __forceinline__ int tid_fresh() { int t = threadIdx.x; asm volatile("" : "+v"(t)); return t; }
__device__ __forceinline__ const char* uni_ptr(const char* p) {
    const unsigned long long v = (unsigned long long)p;
    const unsigned lo = __builtin_amdgcn_readfirstlane((unsigned)v), hi = __builtin_amdgcn_readfirstlane((unsigned)(v >> 32));
    return (const char*)(((unsigned long long)hi << 32) | lo);
}
__device__ __forceinline__ float bf_lo(unsigned w) { return __uint_as_float(w << 16); }
__device__ __forceinline__ float bf_hi(unsigned w) { return __uint_as_float(w & 0xffff0000u); }
__device__ __forceinline__ float fsigmoid(float v) { return __builtin_amdgcn_rcpf(1.0f + __builtin_amdgcn_exp2f(-v * LOG2E)); }
__device__ __forceinline__ float shfl_idx(float v, int srclane) { return __int_as_float(__builtin_amdgcn_ds_bpermute(srclane << 2, __float_as_int(v))); }
__device__ __forceinline__ float wave_sum(float v, int lane) {
#pragma unroll
    for (int o = 1; o < 64; o <<= 1) v += shfl_idx(v, lane ^ o);
    return v;
}
__device__ __forceinline__ int btrow(int row) {
    return (row >> 11) * LP + 64 + (row & 2047);
}

namespace pg8 {
constexpr int BM = 256, BK = 64, HALF = 128, HTB = HALF * BK * 2, STAGE_BYTES = 8 * HTB, NXCD = 8, WGM = 8;
__host__ __device__ __forceinline__ int lds_byte(int r, int c) { const int st = (r >> 4) * 2 + (c >> 5), rr = r & 15, cc = c & 31, ob = rr * 64 + cc * 2; return st * 1024 + (ob ^ (((ob >> 9) & 1) << 5)); }
__host__ __device__ __forceinline__ void stage_rc(int b, int& R, int& C) { const int st = b / 1024, sb = b % 1024, swz = sb ^ (((sb >> 9) & 1) << 5); R = (st >> 1) * 16 + swz / 64; C = (st & 1) * 32 + (swz % 64) / 2; }
__host__ __device__ __forceinline__ int perm32(int rho) { const int n = rho >> 4, i = rho & 15; return 8 * (i >> 2) + 4 * n + (i & 3); }

struct Unit { int pm, pn; };
struct Gemm { const bf16_t* A; const bf16_t* Bt; };

struct StaticOrder {
    int nM, nN, nwg, G, c;
    __host__ __device__ void init(int M, int N, int G_, int c_) { nM = M / BM; nN = N / BM; nwg = nM * nN; G = G_; c = c_; }
    __host__ __device__ bool next(int i, Unit& u) const {
        const long L = (long)i * G + c; if (L >= nwg) return false;
        int wgid = (int)L; { const int q = nwg / NXCD, r = nwg % NXCD, xcd = wgid % NXCD, off = wgid / NXCD; wgid = (xcd < r ? xcd * (q + 1) : r * (q + 1) + (xcd - r) * q) + off; }
        const int nig = WGM * nN, gid = wgid / nig, fm = gid * WGM, gsz = (nM - fm) < WGM ? (nM - fm) : WGM;
        u.pm = fm + ((wgid % nig) % gsz); u.pn = (wgid % nig) / gsz; return true;
    }
};
struct OneUnit {
    Unit u;
    __device__ bool next(int i, Unit& o) const { if (i) return false; o = u; return true; }
};

template <class Epi, class Sched, int LDA, int LDB, int KK, bool ALIGN_EPI = true, bool SP2 = true>
__device__ __forceinline__ void gemm_phase(LAS unsigned char* lds, const Gemm g, const Sched& S, const Epi& E) {
    const int tid = tid_fresh(), wid = __builtin_amdgcn_readfirstlane(tid >> 6), lane = tid & 63, wr = wid >> 2, wc = wid & 3, fr = lane & 15, fq = lane >> 4;
    constexpr int nt = KK / BK;
    unsigned voffA[2], voffB[2];
#pragma unroll
    for (int i = 0; i < 2; ++i) { int R, C; stage_rc(tid * 16 + i * 8192, R, C); const int Rb = Epi::PERM ? ((R & ~31) + perm32(R & 31)) : R;
        voffA[i] = (unsigned)(R * LDA + C) * 2u; voffB[i] = (unsigned)(Rb * LDB + C) * 2u; }
    constexpr size_t kstep = (size_t)(BK * 2);
    constexpr size_t hstepA = (size_t)HALF * LDA * 2, hstepB = (size_t)HALF * LDB * 2;
    constexpr size_t tstepA = 2 * hstepA, tstepB = 2 * hstepB;
    const unsigned ldsw = (unsigned)wid * 1024u;
    const unsigned ldsbase = (unsigned)(size_t)lds + ldsw;
    const int aoff = lds_byte(wr * 64 + fr, fq * 8), boff = lds_byte(wc * 32 + fr, fq * 8);
#define PG8_SA(b, h) (((b) * 2 + (h)) * HTB)
#define PG8_SB(b, h) ((4 + (b) * 2 + (h)) * HTB)
#define PG8_STAGE(bufoff, gbase, voff) do { _Pragma("unroll") for (int _i = 0; _i < 2; ++_i) \
        asm volatile("s_mov_b32 m0, %2\n\ts_nop 0\n\tglobal_load_lds_dwordx4 %0, %1" :: "v"((voff)[_i]), "s"(uni_ptr((const char*)(gbase))), "s"(ldsbase + (unsigned)((bufoff) + _i * 8192)) : "memory", "m0"); } while (0)
#define PG8_LDA(dst, b, h) do { _Pragma("unroll") for (int m = 0; m < 4; ++m) _Pragma("unroll") for (int k = 0; k < 2; ++k) dst[m][k] = *(const LAS bf16x8*)(lds + PG8_SA(b, h) + aoff + m * 2048 + k * 1024); } while (0)
#define PG8_LDB(dst, b, h) do { _Pragma("unroll") for (int n = 0; n < 2; ++n) _Pragma("unroll") for (int k = 0; k < 2; ++k) dst[n][k] = *(const LAS bf16x8*)(lds + PG8_SB(b, h) + boff + n * 2048 + k * 1024); } while (0)
#define PG8_MMA(ai, bj, At, Bt) do { __builtin_amdgcn_s_setprio(1); _Pragma("unroll") for (int m = 0; m < 4; ++m) _Pragma("unroll") for (int n = 0; n < 2; ++n) _Pragma("unroll") for (int k = 0; k < 2; ++k) \
        acc[ai][bj][m][n] = __builtin_amdgcn_mfma_f32_16x16x32_bf16(Bt[n][k], At[m][k], acc[ai][bj][m][n], 0, 0, 0); __builtin_amdgcn_s_setprio(0); } while (0)
#define PG8_WAIT_V(n) asm volatile("s_waitcnt vmcnt(" #n ")" ::: "memory")
#define PG8_WAIT_L(n) asm volatile("s_waitcnt lgkmcnt(" #n ")" ::: "memory")
#define PG8_BAR __builtin_amdgcn_s_barrier()
#define PG8_SCHED __builtin_amdgcn_sched_barrier(0)
    Unit cur, nxt; int ui = 0;
    if (!S.next(0, cur)) return;
    f32x4 acc[2][2][4][2];
#pragma unroll
    for (int a = 0; a < 2; ++a)
#pragma unroll
        for (int b = 0; b < 2; ++b)
#pragma unroll
            for (int m = 0; m < 4; ++m)
#pragma unroll
                for (int n = 0; n < 2; ++n) acc[a][b][m][n] = (f32x4){0.f, 0.f, 0.f, 0.f};
    bf16x8 At[4][2], B0[2][2], B1[2][2];
    const char* cA = (const char*)g.A + (size_t)cur.pm * tstepA; const char* cB = (const char*)g.Bt + (size_t)cur.pn * tstepB;
    if constexpr (SP2) {
        PG8_STAGE(PG8_SB(0, 0), cB, voffB); PG8_STAGE(PG8_SB(0, 1), cB + hstepB, voffB); PG8_STAGE(PG8_SA(0, 0), cA, voffA); PG8_STAGE(PG8_SA(0, 1), cA + hstepA, voffA);
        if (wr == 1) PG8_BAR;
        PG8_WAIT_V(2); PG8_BAR;
        PG8_STAGE(PG8_SB(1, 0), cB + kstep, voffB); PG8_STAGE(PG8_SA(1, 0), cA + kstep, voffA); PG8_STAGE(PG8_SB(1, 1), cB + hstepB + kstep, voffB);
        PG8_WAIT_V(6); PG8_BAR;
    } else {
        PG8_STAGE(PG8_SB(0, 0), cB, voffB); PG8_STAGE(PG8_SA(0, 0), cA, voffA); PG8_STAGE(PG8_SB(0, 1), cB + hstepB, voffB); PG8_STAGE(PG8_SA(0, 1), cA + hstepA, voffA);
        if (wr == 1) PG8_BAR;
        PG8_WAIT_V(4); PG8_BAR;
        PG8_STAGE(PG8_SB(1, 0), cB + kstep, voffB); PG8_STAGE(PG8_SA(1, 0), cA + kstep, voffA); PG8_STAGE(PG8_SB(1, 1), cB + hstepB + kstep, voffB);
        PG8_WAIT_V(6); PG8_BAR;
    }
    for (;;) {
        const bool has_next = S.next(ui + 1, nxt);
        const char* nA = has_next ? (const char*)g.A + (size_t)nxt.pm * tstepA : cA; const char* nB = has_next ? (const char*)g.Bt + (size_t)nxt.pn * tstepB : cB;
#pragma unroll 1
        for (int kh = 0; kh < (Epi::MID ? 2 : 1); ++kh) {
        if constexpr (Epi::MID) { if (kh == 1) E.mid(acc, cur, wr, wc, fr, fq); }
        const int t_end = Epi::MID ? (kh + 1) * (nt / 2) : nt;
#pragma unroll 1
        for (int t = Epi::MID ? kh * (nt / 2) : 0; t < t_end; t += 2) {
            const bool last = (t == nt - 2);
            const char* a1 = cA + (size_t)(t + 1) * kstep;
            const char* a2 = last ? nA : cA + (size_t)(t + 2) * kstep; const char* b2 = last ? nB : cB + (size_t)(t + 2) * kstep;
            const char* a3 = a2 + kstep; const char* b3 = b2 + kstep;
            if constexpr (SP2) {
            PG8_LDB(B0, 0, 0); PG8_LDB(B1, 0, 1); PG8_SCHED; PG8_LDA(At, 0, 0); PG8_STAGE(PG8_SA(1, 1), a1 + hstepA, voffA);
            PG8_WAIT_V(8); PG8_WAIT_L(0); PG8_BAR; PG8_MMA(0, 0, At, B0); PG8_MMA(0, 1, At, B1); PG8_BAR; PG8_SCHED;
            PG8_LDA(At, 0, 1); PG8_STAGE(PG8_SB(0, 0), b2, voffB); PG8_STAGE(PG8_SB(0, 1), b2 + hstepB, voffB); PG8_STAGE(PG8_SA(0, 0), a2, voffA);
            PG8_WAIT_V(8); PG8_WAIT_L(0); PG8_BAR; PG8_MMA(1, 0, At, B0); PG8_MMA(1, 1, At, B1); PG8_BAR; PG8_SCHED;
            PG8_LDB(B0, 1, 0); PG8_LDB(B1, 1, 1); PG8_SCHED; PG8_LDA(At, 1, 0); PG8_STAGE(PG8_SA(0, 1), a2 + hstepA, voffA);
            PG8_WAIT_V(8); PG8_WAIT_L(0); PG8_BAR; PG8_MMA(0, 0, At, B0); PG8_MMA(0, 1, At, B1); PG8_BAR; PG8_SCHED;
            PG8_LDA(At, 1, 1); PG8_STAGE(PG8_SB(1, 0), b3, voffB); PG8_STAGE(PG8_SB(1, 1), b3 + hstepB, voffB); PG8_STAGE(PG8_SA(1, 0), a3, voffA);
            PG8_WAIT_V(8); PG8_WAIT_L(0); PG8_BAR; PG8_MMA(1, 0, At, B0); PG8_MMA(1, 1, At, B1); PG8_BAR; PG8_SCHED;
            } else {
            PG8_LDB(B0, 0, 0); PG8_SCHED; PG8_LDA(At, 0, 0); PG8_STAGE(PG8_SA(1, 1), a1 + hstepA, voffA);
            PG8_WAIT_L(8); PG8_BAR; PG8_WAIT_L(0); PG8_MMA(0, 0, At, B0); PG8_BAR; PG8_SCHED;
            PG8_LDB(B1, 0, 1); PG8_STAGE(PG8_SB(0, 0), b2, voffB);
            PG8_BAR; PG8_WAIT_L(0); PG8_MMA(0, 1, At, B1); PG8_BAR;
            PG8_LDA(At, 0, 1); PG8_STAGE(PG8_SA(0, 0), a2, voffA);
            PG8_BAR; PG8_WAIT_L(0); PG8_MMA(1, 0, At, B0); PG8_BAR; PG8_SCHED;
            PG8_STAGE(PG8_SB(0, 1), b2 + hstepB, voffB);
            PG8_WAIT_V(6); PG8_BAR; PG8_MMA(1, 1, At, B1); PG8_BAR;
            PG8_LDB(B0, 1, 0); PG8_SCHED; PG8_LDA(At, 1, 0); PG8_STAGE(PG8_SA(0, 1), a2 + hstepA, voffA);
            PG8_WAIT_L(8); PG8_BAR; PG8_WAIT_L(0); PG8_MMA(0, 0, At, B0); PG8_BAR; PG8_SCHED;
            PG8_LDB(B1, 1, 1); PG8_STAGE(PG8_SB(1, 0), b3, voffB);
            PG8_BAR; PG8_WAIT_L(0); PG8_MMA(0, 1, At, B1); PG8_BAR;
            PG8_LDA(At, 1, 1); PG8_STAGE(PG8_SA(1, 0), a3, voffA);
            PG8_BAR; PG8_WAIT_L(0); PG8_MMA(1, 0, At, B0); PG8_BAR; PG8_SCHED;
            PG8_STAGE(PG8_SB(1, 1), b3 + hstepB, voffB);
            PG8_WAIT_V(6); PG8_BAR; PG8_MMA(1, 1, At, B1); PG8_BAR;
            }
        }
        }
        if constexpr (ALIGN_EPI) { if (wr == 0) PG8_BAR; }
        E(acc, cur, wr, wc, fr, fq);
        if (!has_next) break;
#pragma unroll
        for (int a = 0; a < 2; ++a)
#pragma unroll
            for (int b = 0; b < 2; ++b)
#pragma unroll
                for (int m = 0; m < 4; ++m)
#pragma unroll
                    for (int n = 0; n < 2; ++n) acc[a][b][m][n] = (f32x4){0.f, 0.f, 0.f, 0.f};
        cur = nxt; cA = nA; cB = nB; ++ui;
        if constexpr (ALIGN_EPI) { if (wr == 1) PG8_BAR; }
    }
    PG8_WAIT_V(0);
    if constexpr (!ALIGN_EPI) { if (wr == 0) PG8_BAR; }
    PG8_BAR;
#undef PG8_SA
#undef PG8_SB
#undef PG8_STAGE
#undef PG8_LDA
#undef PG8_LDB
#undef PG8_MMA
#undef PG8_WAIT_V
#undef PG8_WAIT_L
#undef PG8_BAR
#undef PG8_SCHED
}
}

using pg8::Unit;
struct EpiIn {
    static constexpr bool PERM = true, MID = false;
    unsigned char* ws; const float* ssq;
    __device__ __forceinline__ void operator()(const f32x4 (&acc)[2][2][4][2], const Unit& u, int wr, int wc, int fr, int fq) const {
        const int pn = u.pn; int mode, ld = 1024, cb; size_t boff; bool bt = false;
        if (pn < 4)       { mode = 0; boff = WS_QB; cb = pn * 256; }
        else if (pn < 8)  { mode = 1; boff = WS_KB; cb = (pn - 4) * 256; bt = true; }
        else if (pn < 12) { mode = 1; boff = WS_VB; cb = (pn - 8) * 256; bt = true; }
        else if (pn < 16) { mode = 2; boff = WS_GA; cb = (pn - 12) * 256; }
        else if (pn < 20) { mode = 1; boff = WS_UB; cb = (pn - 16) * 256; bt = true; }
        else if (pn < 24) { mode = 2; boff = WS_GP; cb = (pn - 20) * 256; }
        else if (pn < 32) { mode = 3; boff = WS_SMA; cb = (pn - 24) * 256; ld = 2048; }
        else              { mode = 3; boff = WS_SMP; cb = (pn - 32) * 256; ld = 2048; }
        const int col0 = cb + wc * 32 + 8 * fq;
        float rsv[8];
#pragma unroll
        for (int it = 0; it < 8; ++it) rsv[it] = ssq[(size_t)(u.pm * 256 + (it >> 2) * 128 + wr * 64 + (it & 3) * 16 + fr) * SSQ_STRIDE];
#pragma unroll
        for (int it = 0; it < 8; ++it) rsv[it] = __builtin_amdgcn_rsqf(rsv[it] * (1.0f / DM) + RMS_EPS);
#pragma unroll
        for (int ai = 0; ai < 2; ++ai)
#pragma unroll
            for (int m = 0; m < 4; ++m) {
                const int row = u.pm * 256 + ai * 128 + wr * 64 + m * 16 + fr;
                {
                    const float rs = rsv[ai * 4 + m];
                    const int drow = bt ? btrow(row) : row;
                    bf16_t* rowp = (bf16_t*)(ws + boff) + (size_t)drow * ld + col0;
#pragma unroll
                    for (int bj = 0; bj < 2; ++bj) {
                        f32x4 v0 = acc[ai][bj][m][0] * rs, v1 = acc[ai][bj][m][1] * rs;
                        if (mode == 0) { v0 = v0 * QSCALE; v1 = v1 * QSCALE; }
                        else if (mode == 2) {
#pragma unroll
                            for (int e = 0; e < 4; ++e) { v0[e] = v0[e] * fsigmoid(v0[e]); v1[e] = v1[e] * fsigmoid(v1[e]); }
                        } else if (mode == 3) {
#pragma unroll
                            for (int e = 0; e < 4; ++e) { v0[e] = fsigmoid(v0[e]); v1[e] = fsigmoid(v1[e]); }
                        }
                        u32x4 w; w.x = cvt_pk_bf16(v0[0], v0[1]); w.y = cvt_pk_bf16(v0[2], v0[3]); w.z = cvt_pk_bf16(v1[0], v1[1]); w.w = cvt_pk_bf16(v1[2], v1[3]);
                        *(u32x4*)(rowp + bj * 128) = w;
                    }
                }
                asm volatile("" ::: "memory");
            }
    }
};
struct EpiPool {
    static constexpr bool PERM = true, MID = false;
    const float* scale; const bf16_t* GP; bf16_t* OAP; int g;
    __device__ __forceinline__ void operator()(const f32x4 (&acc)[2][2][4][2], const Unit& u, int wr, int wc, int fr, int fq) const {
        const int col0 = g * 256 + wc * 32 + 8 * fq;
        f32x4 sc[2][2];
#pragma unroll
        for (int bj = 0; bj < 2; ++bj) { sc[bj][0] = *(const f32x4*)(scale + col0 + bj * 128); sc[bj][1] = *(const f32x4*)(scale + col0 + bj * 128 + 4); }
        const int rowb = u.pm * 256 + wr * 64 + fr;
        u32x4 gb[2][2];
#define EP_LD(it, buf) do { const int row_ = rowb + ((it) >> 2) * 128 + ((it) & 3) * 16; const int rr_ = row_ < MROWS ? row_ : MROWS - 1; \
            _Pragma("unroll") for (int bj = 0; bj < 2; ++bj) gb[buf][bj] = *(const u32x4*)(GP + (size_t)rr_ * 1024 + col0 + bj * 128); } while (0)
        EP_LD(0, 0);
#pragma unroll
        for (int it = 0; it < 8; ++it) {
            if (it + 1 < 8) EP_LD(it + 1, (it + 1) & 1);
            const int ai = it >> 2, m = it & 3, row = rowb + ai * 128 + m * 16;
            if (row < MROWS) {
#pragma unroll
                for (int bj = 0; bj < 2; ++bj) {
                    const u32x4 gw = gb[it & 1][bj]; const f32x4 s0 = sc[bj][0], s1 = sc[bj][1];
                    const f32x4 a0 = acc[ai][bj][m][0], a1 = acc[ai][bj][m][1];
                    u32x4 w;
                    w.x = cvt_pk_bf16(a0[0] * s0[0] * bf_lo(gw.x), a0[1] * s0[1] * bf_hi(gw.x));
                    w.y = cvt_pk_bf16(a0[2] * s0[2] * bf_lo(gw.y), a0[3] * s0[3] * bf_hi(gw.y));
                    w.z = cvt_pk_bf16(a1[0] * s1[0] * bf_lo(gw.z), a1[1] * s1[1] * bf_hi(gw.z));
                    w.w = cvt_pk_bf16(a1[2] * s1[2] * bf_lo(gw.w), a1[3] * s1[3] * bf_hi(gw.w));
                    *(u32x4*)(OAP + (size_t)row * 2048 + 1024 + col0 + bj * 128) = w;
                }
            }
            asm volatile("" ::: "memory");
        }
#undef EP_LD
    }
};
struct EpiMerge {
    static constexpr bool PERM = true, MID = true;
    const bf16_t* SMA; const bf16_t* SMP; bf16_t* MG;
    static __device__ __forceinline__ float sfl(float v) { return fmaxf(v, 9.094947e-13f); }
    __device__ __forceinline__ void mid(f32x4 (&acc)[2][2][4][2], const Unit& u, int wr, int wc, int fr, int fq) const {
        asm volatile("" : "+v"(fr), "+v"(fq));
        const int col0 = u.pn * 256 + wc * 32 + 8 * fq;
        const int rowb = u.pm * 256 + wr * 64 + fr;
        u32x4 ga[2][2], gp[2][2];
#define EP_LD(it, buf) do { const size_t off_ = (size_t)(rowb + ((it) >> 2) * 128 + ((it) & 3) * 16) * 2048 + col0; \
            _Pragma("unroll") for (int bj = 0; bj < 2; ++bj) { ga[buf][bj] = *(const u32x4*)(SMA + off_ + bj * 128); gp[buf][bj] = *(const u32x4*)(SMP + off_ + bj * 128); } } while (0)
        EP_LD(0, 0);
#pragma unroll
        for (int it = 0; it < 8; ++it) {
            if (it + 1 < 8) EP_LD(it + 1, (it + 1) & 1);
            const int ai = it >> 2, m = it & 3;
#pragma unroll
            for (int bj = 0; bj < 2; ++bj) {
                const u32x4 a = ga[it & 1][bj], p = gp[it & 1][bj];
                f32x4 r0, r1;
                r0[0] = bf_lo(a.x) * __builtin_amdgcn_rcpf(sfl(bf_lo(p.x))); r0[1] = bf_hi(a.x) * __builtin_amdgcn_rcpf(sfl(bf_hi(p.x)));
                r0[2] = bf_lo(a.y) * __builtin_amdgcn_rcpf(sfl(bf_lo(p.y))); r0[3] = bf_hi(a.y) * __builtin_amdgcn_rcpf(sfl(bf_hi(p.y)));
                r1[0] = bf_lo(a.z) * __builtin_amdgcn_rcpf(sfl(bf_lo(p.z))); r1[1] = bf_hi(a.z) * __builtin_amdgcn_rcpf(sfl(bf_hi(p.z)));
                r1[2] = bf_lo(a.w) * __builtin_amdgcn_rcpf(sfl(bf_lo(p.w))); r1[3] = bf_hi(a.w) * __builtin_amdgcn_rcpf(sfl(bf_hi(p.w)));
                acc[ai][bj][m][0] = acc[ai][bj][m][0] * r0; acc[ai][bj][m][1] = acc[ai][bj][m][1] * r1;
            }
            asm volatile("" ::: "memory");
        }
#undef EP_LD
    }
    __device__ __forceinline__ void operator()(const f32x4 (&acc)[2][2][4][2], const Unit& u, int wr, int wc, int fr, int fq) const {
        const int col0 = u.pn * 256 + wc * 32 + 8 * fq;
        const int rowb = u.pm * 256 + wr * 64 + fr;
        u32x4 gp[2][2];
#define EP_LD(it, buf) do { const size_t off_ = (size_t)(rowb + ((it) >> 2) * 128 + ((it) & 3) * 16) * 2048 + col0; \
            _Pragma("unroll") for (int bj = 0; bj < 2; ++bj) gp[buf][bj] = *(const u32x4*)(SMP + off_ + bj * 128); } while (0)
        EP_LD(0, 0);
#pragma unroll
        for (int it = 0; it < 8; ++it) {
            if (it + 1 < 8) EP_LD(it + 1, (it + 1) & 1);
            const int ai = it >> 2, m = it & 3;
            const size_t off = (size_t)(rowb + ai * 128 + m * 16) * 2048 + col0;
#pragma unroll
            for (int bj = 0; bj < 2; ++bj) {
                const u32x4 p = gp[it & 1][bj];
                const f32x4 a0 = acc[ai][bj][m][0], a1 = acc[ai][bj][m][1];
                u32x4 w;
                w.x = cvt_pk_bf16(a0[0] * sfl(bf_lo(p.x)), a0[1] * sfl(bf_hi(p.x)));
                w.y = cvt_pk_bf16(a0[2] * sfl(bf_lo(p.y)), a0[3] * sfl(bf_hi(p.y)));
                w.z = cvt_pk_bf16(a1[0] * sfl(bf_lo(p.z)), a1[1] * sfl(bf_hi(p.z)));
                w.w = cvt_pk_bf16(a1[2] * sfl(bf_lo(p.w)), a1[3] * sfl(bf_hi(p.w)));
                *(u32x4*)(MG + off + bj * 128) = w;
            }
            asm volatile("" ::: "memory");
        }
#undef EP_LD
    }
};
struct EpiRes {
    static constexpr bool PERM = true, MID = false;
    const float* XIN; float* XS; bf16_t* HB; float* ssq;
    __device__ __forceinline__ void operator()(const f32x4 (&acc)[2][2][4][2], const Unit& u, int wr, int wc, int fr, int fq) const {
        const int col0 = u.pn * 256 + wc * 32 + 8 * fq;
        const int rowb = u.pm * 256 + wr * 64 + fr;
        const int lane = fq * 16 + fr;
        f32x4 xb[2][2][2];
#define EP_LD(it, buf) do { const size_t off_ = (size_t)(rowb + ((it) >> 2) * 128 + ((it) & 3) * 16) * 2048 + col0; \
            _Pragma("unroll") for (int bj = 0; bj < 2; ++bj) { xb[buf][bj][0] = *(const f32x4*)(XIN + off_ + bj * 128); xb[buf][bj][1] = *(const f32x4*)(XIN + off_ + bj * 128 + 4); } } while (0)
        EP_LD(0, 0);
#pragma unroll
        for (int it = 0; it < 8; ++it) {
            if (it + 1 < 8) EP_LD(it + 1, (it + 1) & 1);
            const int ai = it >> 2, m = it & 3, row = rowb + ai * 128 + m * 16;
            const size_t off = (size_t)row * 2048 + col0;
            float sq = 0.f;
#pragma unroll
            for (int bj = 0; bj < 2; ++bj) {
                const f32x4 n0 = xb[it & 1][bj][0] + acc[ai][bj][m][0], n1 = xb[it & 1][bj][1] + acc[ai][bj][m][1];
                *(f32x4*)(XS + off + bj * 128) = n0; *(f32x4*)(XS + off + bj * 128 + 4) = n1;
                u32x4 w; w.x = cvt_pk_bf16(n0[0], n0[1]); w.y = cvt_pk_bf16(n0[2], n0[3]); w.z = cvt_pk_bf16(n1[0], n1[1]); w.w = cvt_pk_bf16(n1[2], n1[3]);
                if (HB) *(u32x4*)(HB + off + bj * 128) = w;
                sq += (n0[0] * n0[0] + n0[1] * n0[1]) + (n0[2] * n0[2] + n0[3] * n0[3]) + (n1[0] * n1[0] + n1[1] * n1[1]) + (n1[2] * n1[2] + n1[3] * n1[3]);
            }
            sq += shfl_idx(sq, lane ^ 16); sq += shfl_idx(sq, lane ^ 32);
            if (fq == 0) atomicAdd(ssq + (size_t)row * SSQ_STRIDE, sq);
            asm volatile("" ::: "memory");
        }
#undef EP_LD
    }
};

struct EpiResFinal {
    static constexpr bool PERM = true, MID = false;
    const float* XIN; const float* gain; float* OUT; float* ssq; unsigned* pcnt;
    __device__ __forceinline__ void operator()(const f32x4 (&acc_c)[2][2][4][2], const Unit& u, int wr, int wc, int fr, int fq) const {
        f32x4 (&acc)[2][2][4][2] = const_cast<f32x4 (&)[2][2][4][2]>(acc_c);
        const int col0 = u.pn * 256 + wc * 32 + 8 * fq;
        const int rowb = u.pm * 256 + wr * 64 + fr;
        const int lane = fq * 16 + fr;
        f32x4 xb[2][2][2];
#define EP_LD(it, buf) do { const size_t off_ = (size_t)(rowb + ((it) >> 2) * 128 + ((it) & 3) * 16) * 2048 + col0; \
            _Pragma("unroll") for (int bj = 0; bj < 2; ++bj) { xb[buf][bj][0] = *(const f32x4*)(XIN + off_ + bj * 128); xb[buf][bj][1] = *(const f32x4*)(XIN + off_ + bj * 128 + 4); } } while (0)
        EP_LD(0, 0);
#pragma unroll
        for (int it = 0; it < 8; ++it) {
            if (it + 1 < 8) EP_LD(it + 1, (it + 1) & 1);
            const int ai = it >> 2, m = it & 3, row = rowb + ai * 128 + m * 16;
            float sq = 0.f;
#pragma unroll
            for (int bj = 0; bj < 2; ++bj) {
                const f32x4 n0 = xb[it & 1][bj][0] + acc[ai][bj][m][0], n1 = xb[it & 1][bj][1] + acc[ai][bj][m][1];
                acc[ai][bj][m][0] = n0; acc[ai][bj][m][1] = n1;
                sq += (n0[0] * n0[0] + n0[1] * n0[1]) + (n0[2] * n0[2] + n0[3] * n0[3]) + (n1[0] * n1[0] + n1[1] * n1[1]) + (n1[2] * n1[2] + n1[3] * n1[3]);
            }
            sq += shfl_idx(sq, lane ^ 16); sq += shfl_idx(sq, lane ^ 32);
            if (fq == 0) atomicAdd(ssq + (size_t)row * SSQ_STRIDE, sq);
            asm volatile("" ::: "memory");
        }
#undef EP_LD
        asm volatile("s_waitcnt vmcnt(0)" ::: "memory");
        __syncthreads();
        if (tid_fresh() == 0) {
            unsigned* pc = pcnt + u.pm * 16;
            __hip_atomic_fetch_add(pc, 1u, __ATOMIC_RELAXED, __HIP_MEMORY_SCOPE_AGENT);
            unsigned sp = 0;
            while (__hip_atomic_load(pc, __ATOMIC_RELAXED, __HIP_MEMORY_SCOPE_AGENT) < 8u && ++sp < (1u << 20)) __builtin_amdgcn_s_sleep(1);
        }
        __syncthreads();
        f32x4 gv[2][2];
#pragma unroll
        for (int bj = 0; bj < 2; ++bj) { gv[bj][0] = *(const f32x4*)(gain + col0 + bj * 128); gv[bj][1] = *(const f32x4*)(gain + col0 + bj * 128 + 4); }
        float ssv[8];
#pragma unroll
        for (int it = 0; it < 8; ++it) ssv[it] = __hip_atomic_load(ssq + (size_t)(rowb + (it >> 2) * 128 + (it & 3) * 16) * SSQ_STRIDE, __ATOMIC_RELAXED, __HIP_MEMORY_SCOPE_AGENT);
#pragma unroll
        for (int it = 0; it < 8; ++it) {
            const int ai = it >> 2, m = it & 3;
            const float r = __builtin_amdgcn_rsqf(ssv[it] * (1.0f / DM) + RMS_EPS);
            const size_t off = (size_t)(rowb + ai * 128 + m * 16) * 2048 + col0;
#pragma unroll
            for (int bj = 0; bj < 2; ++bj) {
                *(f32x4*)(OUT + off + bj * 128) = acc[ai][bj][m][0] * r * gv[bj][0]; *(f32x4*)(OUT + off + bj * 128 + 4) = acc[ai][bj][m][1] * r * gv[bj][1];
            }
        }
    }
};

struct Args {
    const float* x; const float* meta; const float* norm_gain; const float* w_in; const float* pool_w; const float* pool_scale;
    const float* w_attn_up; const float* w_pool_up; const float* w_out; const float* final_gain;
    float* out; unsigned char* ws; int ph_lo, ph_hi;
};

__device__ __forceinline__ void transpose_item(const float* W, int N, bf16_t* WT, int ldwt, int coff, LAS float* scr, int kb, int nb, int lane, const float* kgain = nullptr) {
    const int k0 = 64 * kb, n0 = 32 * nb;
    float tv[32];
#pragma unroll
    for (int i = 0; i < 32; ++i) { const int kk = 2 * i + (lane >> 5); tv[i] = W[(size_t)(k0 + kk) * N + n0 + (lane & 31)]; }
    if (kgain) {
#pragma unroll
        for (int i = 0; i < 32; ++i) tv[i] *= kgain[k0 + 2 * i + (lane >> 5)];
    }
#pragma unroll
    for (int i = 0; i < 32; ++i) { const int kk = 2 * i + (lane >> 5); scr[kk * 33 + (lane & 31)] = tv[i]; }
    asm volatile("s_waitcnt lgkmcnt(0)" ::: "memory");
    const int c = lane & 7;
#pragma unroll
    for (int j = 0; j < 4; ++j) { const int n = (lane >> 3) + 8 * j; const LAS float* s = scr + (8 * c) * 33 + n;
        u32x4 o; o.x = cvt_pk_bf16(s[0 * 33], s[1 * 33]); o.y = cvt_pk_bf16(s[2 * 33], s[3 * 33]); o.z = cvt_pk_bf16(s[4 * 33], s[5 * 33]); o.w = cvt_pk_bf16(s[6 * 33], s[7 * 33]);
        *(u32x4*)(WT + (size_t)(n0 + n) * ldwt + coff + k0 + 8 * c) = o; }
    asm volatile("s_waitcnt lgkmcnt(0)" ::: "memory");
}
__device__ __forceinline__ void rms_row_bf16(const float* xrow, const float* gain, bf16_t* orow, float* xs_out, int lane) {
    const f32x4* xr = (const f32x4*)xrow + lane;
    f32x4 v[8]; float s = 0.f;
#pragma unroll
    for (int j = 0; j < 8; ++j) { v[j] = xr[64 * j]; s += (v[j][0] * v[j][0] + v[j][1] * v[j][1]) + (v[j][2] * v[j][2] + v[j][3] * v[j][3]); }
    const float r = 1.0f / sqrtf(wave_sum(s, lane) * (1.0f / DM) + RMS_EPS);
    if (xs_out) {
#pragma unroll
        for (int j = 0; j < 8; ++j) ((f32x4*)xs_out + lane)[64 * j] = v[j];
    }
    const f32x4* gr = (const f32x4*)gain + lane;
    u32x2* o8 = (u32x2*)orow + lane;
#pragma unroll
    for (int j = 0; j < 8; ++j) { const f32x4 g = gr[64 * j]; u32x2 w; w.x = cvt_pk_bf16(v[j][0] * r * g[0], v[j][1] * r * g[1]); w.y = cvt_pk_bf16(v[j][2] * r * g[2], v[j][3] * r * g[3]); o8[64 * j] = w; }
}
__device__ __forceinline__ void init_row(const float* xrow, bf16_t* hrow, float* ssq, int lane) {
    const f32x4* xr = (const f32x4*)xrow + lane;
    f32x4 v[8]; float s = 0.f;
#pragma unroll
    for (int j = 0; j < 8; ++j) { v[j] = xr[64 * j]; s += (v[j][0] * v[j][0] + v[j][1] * v[j][1]) + (v[j][2] * v[j][2] + v[j][3] * v[j][3]); }
    s = wave_sum(s, lane);
    u32x2* o8 = (u32x2*)hrow + lane;
#pragma unroll
    for (int j = 0; j < 8; ++j) { u32x2 w; w.x = cvt_pk_bf16(v[j][0], v[j][1]); w.y = cvt_pk_bf16(v[j][2], v[j][3]); o8[64 * j] = w; }
    if (lane == 0) *ssq = s;
}
__device__ __forceinline__ void final_row(const float* xrow, const float* gain, float* orow, const float ssq, int lane) {
    const float r = 1.0f / sqrtf(ssq * (1.0f / DM) + RMS_EPS);
    const f32x4* xr = (const f32x4*)xrow + lane; const f32x4* gr = (const f32x4*)gain + lane;
#pragma unroll
    for (int j = 0; j < 8; ++j) ((f32x4*)orow + lane)[64 * j] = xr[64 * j] * r * gr[64 * j];
}
__device__ __forceinline__ void rms_row_f32(const float* xrow, const float* gain, float* orow, int lane) {
    const f32x4* xr = (const f32x4*)xrow + lane;
    f32x4 v[8]; float s = 0.f;
#pragma unroll
    for (int j = 0; j < 8; ++j) { v[j] = xr[64 * j]; s += (v[j][0] * v[j][0] + v[j][1] * v[j][1]) + (v[j][2] * v[j][2] + v[j][3] * v[j][3]); }
    const float r = 1.0f / sqrtf(wave_sum(s, lane) * (1.0f / DM) + RMS_EPS);
    const f32x4* gr = (const f32x4*)gain + lane;
#pragma unroll
    for (int j = 0; j < 8; ++j) { const f32x4 g = gr[64 * j]; ((f32x4*)orow + lane)[64 * j] = v[j] * r * g; }
}

constexpr int KS = 272;
constexpr int TILEB = 64 * KS;
constexpr int KTILEB = 64 * 256;
constexpr int ABUF = KTILEB + TILEB;
__device__ __forceinline__ float fexp2(float x) { return __builtin_amdgcn_exp2f(x); }
__device__ __forceinline__ float frcp(float x) { return __builtin_amdgcn_rcpf(x); }

__device__ __forceinline__ void attn_tile(LAS unsigned char* Kb, const int j, const int tq0, const int tq, const int l, const int lg, const int (&kofs)[4], const int vbase,
                                          const bf16x8 (&qf)[4], f32x4 (&o)[8], float& P) {
    LAS unsigned char* Vb = Kb + KTILEB;
    f32x4 s[4];
    float zf = 0.f; asm volatile("" : "+v"(zf));
#pragma unroll
    for (int g = 0; g < 4; ++g) s[g] = (f32x4){zf, zf, zf, zf};
#pragma unroll
    for (int dc = 0; dc < 4; ++dc)
#pragma unroll
        for (int g = 0; g < 4; ++g) { const bf16x8 kf = *(const LAS bf16x8*)(Kb + kofs[dc] + g * 1024); s[g] = __builtin_amdgcn_mfma_f32_16x16x32_bf16(kf, qf[dc], s[g], 0, 0, 0); }
    const bool need_mask = (64 * j + 63 >= tq0) || (j == 0);
    float beta[16], omb[16];
#pragma unroll
    for (int kk = 0; kk < 16; ++kk) {
        const float t = fexp2(-s[kk >> 2][kk & 3]), r = frcp(1.0f + t);
        beta[kk] = r; omb[kk] = 1.0f - r;
    }
    if (need_mask) {
        const int tk0 = 64 * j + 16 * lg;
#pragma unroll
        for (int kk = 0; kk < 16; ++kk) { const int tk = tk0 + kk; const bool valid = (tk >= TOFF) && (tk < tq); beta[kk] = valid ? beta[kk] : 0.0f; omb[kk] = valid ? omb[kk] : 1.0f; }
    }
    float e[16]; e[15] = 1.0f;
#pragma unroll
    for (int kk = 14; kk >= 0; --kk) e[kk] = e[kk + 1] * omb[kk + 1];
    const float T = e[0] * omb[0];
    const float T1 = shfl_idx(T, (l + 16) & 63), T2 = shfl_idx(T, (l + 32) & 63), T3 = shfl_idx(T, (l + 48) & 63);
    float G = 1.0f;
    if (lg <= 2) G *= T1;
    if (lg <= 1) G *= T2;
    if (lg == 0) G *= T3;
    const float c = P * G;
    P = P * ((T * T1) * (T2 * T3));
    float a[16];
#pragma unroll
    for (int kk = 0; kk < 16; ++kk) a[kk] = beta[kk] * (e[kk] * c);
    bf16x8 pa[2];
#pragma unroll
    for (int mm = 0; mm < 2; ++mm) {
        u32x4 wv; wv.x = cvt_pk_bf16(a[8 * mm + 0], a[8 * mm + 1]); wv.y = cvt_pk_bf16(a[8 * mm + 2], a[8 * mm + 3]); wv.z = cvt_pk_bf16(a[8 * mm + 4], a[8 * mm + 5]); wv.w = cvt_pk_bf16(a[8 * mm + 6], a[8 * mm + 7]);
        pa[mm] = __builtin_bit_cast(bf16x8, wv);
    }
#pragma unroll
    for (int dg = 0; dg < 8; ++dg)
#pragma unroll
        for (int mm = 0; mm < 2; ++mm) {
            const s16x4 v0 = __builtin_bit_cast(s16x4, __builtin_amdgcn_ds_read_tr16_b64_v4i16((LAS s16x4*)(Vb + vbase + (8 * mm) * KS + dg * 32)));
            const s16x4 v1 = __builtin_bit_cast(s16x4, __builtin_amdgcn_ds_read_tr16_b64_v4i16((LAS s16x4*)(Vb + vbase + (8 * mm + 4) * KS + dg * 32)));
            const bf16x8 vf = __builtin_shufflevector(v0, v1, 0, 1, 2, 3, 4, 5, 6, 7);
            o[dg] = __builtin_amdgcn_mfma_f32_16x16x32_bf16(vf, pa[mm], o[dg], 0, 0, 0);
        }
}

__device__ __forceinline__ void attn_unit(LAS unsigned char* lds, const bf16_t* __restrict__ QB, const bf16_t* __restrict__ KB, const bf16_t* __restrict__ VB,
                                          const bf16_t* __restrict__ GA, bf16_t* __restrict__ OAP, int b, int h, int qb) {
    const int tid = tid_fresh(), w = __builtin_amdgcn_readfirstlane(tid >> 6), l = tid & 63, qi = l & 15, lg = l >> 4;
    const int tq0 = 64 + 128 * qb + 16 * w;
    const bool wactive = (tq0 >= TOFF);
    const int tq = tq0 + qi;
    const int mrow = (tq0 >= 64) ? (b * 2048 + tq - 64) : (MREAL + (wactive ? tq - TOFF : 0));
    const int jtop = (qb >= 0) ? 2 * qb + 2 : 0, ntiles = jtop + 1;
    const int jw = wactive ? ((tq0 + 14) >> 6) : -1;
    bf16x8 qf[4];
#pragma unroll
    for (int dc = 0; dc < 4; ++dc) qf[dc] = *(const bf16x8*)(QB + (size_t)mrow * 1024 + h * 128 + dc * 32 + lg * 8);
    f32x4 o[8];
#pragma unroll
    for (int dg = 0; dg < 8; ++dg) o[dg] = (f32x4){0.f, 0.f, 0.f, 0.f};
    float P = 1.0f;
    const size_t gbase = ((size_t)b * LP) * 1024 + h * 128;
    u32x4 kr0[2], vr0[2], kr1[2], vr1[2];
#define ATT_GLOAD(KR, VR, j) do { _Pragma("unroll") for (int i_ = 0; i_ < 2; ++i_) { const int p_ = tid + 512 * i_, r_ = p_ >> 4, c_ = p_ & 15; const size_t off_ = gbase + (size_t)(64 * (j) + r_) * 1024 + c_ * 8; \
        KR[i_] = *(const u32x4*)(KB + off_); VR[i_] = *(const u32x4*)(VB + off_); } } while (0)
#define ATT_LWRITE(KR, VR, buf) do { _Pragma("unroll") for (int i_ = 0; i_ < 2; ++i_) { const int p_ = tid + 512 * i_, r_ = p_ >> 4, c_ = p_ & 15; \
        *(LAS u32x4*)(lds + (buf) * ABUF + r_ * 256 + ((c_ ^ ((r_ & 3) | (((r_ >> 4) & 3) << 2))) << 4)) = KR[i_]; *(LAS u32x4*)(lds + (buf) * ABUF + KTILEB + r_ * KS + c_ * 16) = VR[i_]; } } while (0)
    LAS volatile int* flags = (LAS volatile int*)(lds + MISC_OFF + 64);
    ATT_GLOAD(kr0, vr0, jtop);
    u32x2 gwv[8];
#pragma unroll
    for (int dg = 0; dg < 8; ++dg) gwv[dg] = *(const u32x2*)(GA + (size_t)mrow * 1024 + h * 128 + 16 * dg + 4 * lg);
    if (ntiles > 1) ATT_GLOAD(kr1, vr1, jtop - 1);
    ATT_LWRITE(kr0, vr0, 0);
    __syncthreads();
    int kofs[4];
#pragma unroll
    for (int dc = 0; dc < 4; ++dc) kofs[dc] = (16 * (qi >> 2) + (qi & 3)) * 256 + (((4 * dc + lg) ^ qi) << 4);
    const int vbase = (16 * lg + (qi >> 2)) * KS + (qi & 3) * 8;
#define ATT_ITER(it, KRF, VRF, KRN, VRN) { \
        const int j = jtop - (it), cur = (it) & 1; \
        if ((it) + 2 < ntiles) ATT_GLOAD(KRF, VRF, j - 2); \
        if (j <= jw) attn_tile(lds + cur * ABUF, j, tq0, tq, l, lg, kofs, vbase, qf, o, P); \
        if ((it) + 1 < ntiles) ATT_LWRITE(KRN, VRN, cur ^ 1); \
        { const bool wdone = !wactive || (j <= jw && __builtin_amdgcn_ballot_w64(P != 0.0f) == 0ull); \
          if (l == 0) flags[cur * 8 + w] = wdone ? 1 : 0; } \
        __syncthreads(); \
        { int alld = 1; _Pragma("unroll") for (int ww = 0; ww < 8; ++ww) alld &= flags[cur * 8 + ww]; if (alld) break; } }
    for (int it = 0; it < ntiles; it += 2) {
        ATT_ITER(it, kr0, vr0, kr1, vr1)
        if (it + 1 >= ntiles) break;
        ATT_ITER(it + 1, kr1, vr1, kr0, vr0)
    }
#undef ATT_ITER
#undef ATT_GLOAD
#undef ATT_LWRITE
    if (wactive) {
#pragma unroll
        for (int dg = 0; dg < 8; ++dg) {
            const size_t col = (size_t)h * 128 + 16 * dg + 4 * lg;
            const u32x2 gw = gwv[dg];
            u32x2 wv; wv.x = cvt_pk_bf16(o[dg][0] * bf_lo(gw.x), o[dg][1] * bf_hi(gw.x)); wv.y = cvt_pk_bf16(o[dg][2] * bf_lo(gw.y), o[dg][3] * bf_hi(gw.y));
            *(u32x2*)(OAP + (size_t)mrow * 2048 + col) = wv;
        }
    }
}

__device__ __forceinline__ void load8f(const bf16_t* p, float (&f)[8]) {
    const u32x4 w = *(const u32x4*)p;
    f[0] = bf_lo(w.x); f[1] = bf_hi(w.x); f[2] = bf_lo(w.y); f[3] = bf_hi(w.y); f[4] = bf_lo(w.z); f[5] = bf_hi(w.z); f[6] = bf_lo(w.w); f[7] = bf_hi(w.w);
}
template <int W>
__device__ __forceinline__ void pool_prepass(const bf16_t* __restrict__ up, bf16_t* __restrict__ op, const int t0) {
    u32x4 raw[W - 1 + 16];
#pragma unroll
    for (int r = 0; r < W - 1 + 16; ++r) raw[r] = *(const u32x4*)(up + (ptrdiff_t)(r - (W - 1)) * 1024);
    float S[8];
#pragma unroll
    for (int e = 0; e < 8; ++e) S[e] = 0.f;
#pragma unroll
    for (int r = 0; r < W - 1; ++r) { const u32x4 q = raw[r]; S[0] += bf_lo(q.x); S[1] += bf_hi(q.x); S[2] += bf_lo(q.y); S[3] += bf_hi(q.y); S[4] += bf_lo(q.z); S[5] += bf_hi(q.z); S[6] += bf_lo(q.w); S[7] += bf_hi(q.w); }
#pragma unroll
    for (int rr = 0; rr < 16; ++rr) {
        const u32x4 q = raw[W - 1 + rr];
        float cu[8] = {bf_lo(q.x), bf_hi(q.x), bf_lo(q.y), bf_hi(q.y), bf_lo(q.z), bf_hi(q.z), bf_lo(q.w), bf_hi(q.w)};
        if (rr > 0) { const u32x4 p = raw[rr - 1]; S[0] -= bf_lo(p.x); S[1] -= bf_hi(p.x); S[2] -= bf_lo(p.y); S[3] -= bf_hi(p.y); S[4] -= bf_lo(p.z); S[5] -= bf_hi(p.z); S[6] -= bf_lo(p.w); S[7] -= bf_hi(p.w); }
#pragma unroll
        for (int e = 0; e < 8; ++e) S[e] += cu[e];
        const int t = t0 + rr; const float inv = 1.0f / (float)((t + 1) < W ? (t + 1) : W);
        u32x4 o; o.x = cvt_pk_bf16(S[0] * inv - cu[0], S[1] * inv - cu[1]); o.y = cvt_pk_bf16(S[2] * inv - cu[2], S[3] * inv - cu[3]);
        o.z = cvt_pk_bf16(S[4] * inv - cu[4], S[5] * inv - cu[5]); o.w = cvt_pk_bf16(S[6] * inv - cu[6], S[7] * inv - cu[7]);
        *(u32x4*)(op + (size_t)rr * 1024) = o;
    }
}
__device__ __forceinline__ void pool_unit(LAS unsigned char* lds, const bf16_t* __restrict__ UB, bf16_t* __restrict__ PL, const bf16_t* PWT  , const float* scale  ,
                                          const bf16_t* GP, bf16_t* OAP, int pm, int g) {
    const int tid = tid_fresh(), cc = tid & 31, strip = tid >> 5;
    int b, tb, m0; bool valid = true;
    if (pm < 32) { const int r0 = pm * 256 + strip * 16; b = r0 >> 11; tb = 64 + (r0 & 2047); m0 = r0; }
    else { b = 0; tb = TOFF; m0 = MREAL; valid = strip == 0; }
    if (valid) {
        const bf16_t* up = UB + ((size_t)(b * LP + tb)) * 1024 + g * 256 + cc * 8;
        bf16_t* op = PL + (size_t)m0 * 1024 + g * 256 + cc * 8;
        if (g == 0) pool_prepass<2>(up, op, tb - TOFF);
        else if (g == 1) pool_prepass<4>(up, op, tb - TOFF);
        else if (g == 2) pool_prepass<8>(up, op, tb - TOFF);
        else pool_prepass<16>(up, op, tb - TOFF);
    }
    asm volatile("s_waitcnt vmcnt(0)" ::: "memory");
    __syncthreads();
    pg8::Gemm gm{PL + g * 256, PWT + (size_t)g * GD * GD};
    pg8::OneUnit S1{{pm, 0}};
    EpiPool E{scale, GP, OAP, g};
    pg8::gemm_phase<EpiPool, pg8::OneUnit, 1024, 256, 256>(lds, gm, S1, E);
}

__device__ __forceinline__ f32x4 skinny_part(const bf16_t* __restrict__ wp, const bf16_t* __restrict__ hp) {
    bf16x8 wv[8], hv[8];
#pragma unroll
    for (int u = 0; u < 8; ++u) { wv[u] = *(const bf16x8*)(wp + 32 * u); hv[u] = *(const bf16x8*)(hp + 32 * u); }
    f32x4 acc = (f32x4){0.f, 0.f, 0.f, 0.f};
#pragma unroll
    for (int u = 0; u < 8; ++u) acc = __builtin_amdgcn_mfma_f32_16x16x32_bf16(wv[u], hv[u], acc, 0, 0, 0);
    return acc;
}
__device__ __forceinline__ void skinny_reduce(LAS unsigned char* lds, const f32x4 part, const int wave, const int lane, f32x4& lo4, f32x4& hi4) {
    LAS f32x4* red = (LAS f32x4*)lds;
    __syncthreads();
    red[wave * 64 + lane] = part;
    __syncthreads();
    if (wave == 0) {
        lo4 = (red[lane] + red[64 + lane]) + (red[128 + lane] + red[192 + lane]);
        hi4 = (red[256 + lane] + red[320 + lane]) + (red[384 + lane] + red[448 + lane]);
    }
}
__device__ __forceinline__ void skinny_in(LAS unsigned char* lds, unsigned char* ws, const bf16_t* WINL, const float* ssq, const int bx, const int G, const int wave, const int lane) {
    const bf16_t* HB = (const bf16_t*)(ws + WS_HB);
    const int t = lane & 15, g4 = lane >> 4;
    for (int nt = bx; nt < INC / 16; nt += G) {
        const int n0 = nt * 16;
        const f32x4 part = skinny_part(WINL + (size_t)(n0 + t) * DM + wave * 256 + g4 * 8, HB + (size_t)(MREAL + t) * DM + wave * 256 + g4 * 8);
        f32x4 lo4, hi4; skinny_reduce(lds, part, wave, lane, lo4, hi4);
        if (wave == 0) {
            f32x4 v = (lo4 + hi4) * __builtin_amdgcn_rsqf(ssq[(size_t)(MREAL + t) * SSQ_STRIDE] * (1.0f / DM) + RMS_EPS);
            const int c = n0 + 4 * g4;
            int mode, ld = 1024, cb; size_t boff; bool bt = false;
            if (c < 1024)      { mode = 0; boff = WS_QB; cb = c; }
            else if (c < 2048) { mode = 1; boff = WS_KB; cb = c - 1024; bt = true; }
            else if (c < 3072) { mode = 1; boff = WS_VB; cb = c - 2048; bt = true; }
            else if (c < 4096) { mode = 2; boff = WS_GA; cb = c - 3072; }
            else if (c < 5120) { mode = 1; boff = WS_UB; cb = c - 4096; bt = true; }
            else if (c < 6144) { mode = 2; boff = WS_GP; cb = c - 5120; }
            else if (c < 8192) { mode = 3; boff = WS_SMA; cb = c - 6144; ld = 2048; }
            else               { mode = 3; boff = WS_SMP; cb = c - 8192; ld = 2048; }
            if (mode == 0) v = v * QSCALE;
            else if (mode == 2) { for (int e = 0; e < 4; ++e) v[e] = v[e] * fsigmoid(v[e]); }
            else if (mode == 3) { for (int e = 0; e < 4; ++e) v[e] = fsigmoid(v[e]); }
            u32x2 w; w.x = cvt_pk_bf16(v[0], v[1]); w.y = cvt_pk_bf16(v[2], v[3]);
            bf16_t* base = (bf16_t*)(ws + boff);
            if (bt) {
#pragma unroll
                for (int b = 0; b < NB; ++b) *(u32x2*)(base + (size_t)(b * LP + TOFF + t) * 1024 + cb) = w;
            } else *(u32x2*)(base + (size_t)(MREAL + t) * ld + cb) = w;
        }
    }
}
__device__ __forceinline__ void skinny_merge(LAS unsigned char* lds, unsigned char* ws, const bf16_t* WML, const int bx, const int G, const int wave, const int lane) {
    const bf16_t* OAP = (const bf16_t*)(ws + WS_OAP); const bf16_t* SMA = (const bf16_t*)(ws + WS_SMA); const bf16_t* SMP = (const bf16_t*)(ws + WS_SMP); bf16_t* MG = (bf16_t*)(ws + WS_MG);
    const int t = lane & 15, g4 = lane >> 4;
    for (int nt = bx; nt < DM / 16; nt += G) {
        const int n0 = nt * 16;
        const f32x4 part = skinny_part(WML + (size_t)(n0 + t) * DM + wave * 256 + g4 * 8, OAP + (size_t)(MREAL + t) * DM + wave * 256 + g4 * 8);
        f32x4 y1, y2; skinny_reduce(lds, part, wave, lane, y1, y2);
        if (wave == 0) {
            const size_t off = (size_t)(MREAL + t) * DM + n0 + 4 * g4;
            const u32x2 ga = *(const u32x2*)(SMA + off), gp = *(const u32x2*)(SMP + off);
            u32x2 w;
            w.x = cvt_pk_bf16(y1[0] * bf_lo(ga.x) + y2[0] * bf_lo(gp.x), y1[1] * bf_hi(ga.x) + y2[1] * bf_hi(gp.x));
            w.y = cvt_pk_bf16(y1[2] * bf_lo(ga.y) + y2[2] * bf_lo(gp.y), y1[3] * bf_hi(ga.y) + y2[3] * bf_hi(gp.y));
            *(u32x2*)(MG + off) = w;
        }
    }
}
__device__ __forceinline__ void skinny_out(LAS unsigned char* lds, unsigned char* ws, const bf16_t* WOL, const float* xin  , float* ssq, const int bx, const int G, const int wave, const int lane) {
    const bf16_t* MG = (const bf16_t*)(ws + WS_MG); float* XS = (float*)(ws + WS_XS); bf16_t* HB = (bf16_t*)(ws + WS_HB);
    const int t = lane & 15, g4 = lane >> 4;
    for (int nt = bx; nt < DM / 16; nt += G) {
        const int n0 = nt * 16;
        const f32x4 part = skinny_part(WOL + (size_t)(n0 + t) * DM + wave * 256 + g4 * 8, MG + (size_t)(MREAL + t) * DM + wave * 256 + g4 * 8);
        f32x4 lo4, hi4; skinny_reduce(lds, part, wave, lane, lo4, hi4);
        if (wave == 0) {
            f32x4* xp = (f32x4*)(XS + (size_t)(MREAL + t) * DM + n0 + 4 * g4);
            const f32x4 nv = *(const f32x4*)(xin + (size_t)t * DM + n0 + 4 * g4) + (lo4 + hi4);
            *xp = nv;
            u32x2 w; w.x = cvt_pk_bf16(nv[0], nv[1]); w.y = cvt_pk_bf16(nv[2], nv[3]);
            *(u32x2*)(HB + (size_t)(MREAL + t) * DM + n0 + 4 * g4) = w;
            float sq = (nv[0] * nv[0] + nv[1] * nv[1]) + (nv[2] * nv[2] + nv[3] * nv[3]);
            sq += shfl_idx(sq, lane ^ 16); sq += shfl_idx(sq, lane ^ 32);
            if (g4 == 0) atomicAdd(ssq + (size_t)(MREAL + t) * SSQ_STRIDE, sq);
        }
    }
}

constexpr int PH_PRO = 0, PH_FINAL = 1 + 5 * DEPTH, N_PHASES = PH_FINAL + 1;
constexpr int N_ATT = 32 * 16, N_POOLU = 33 * 4, N_METAU = 8, N_BITEMS = N_ATT + N_POOLU + N_METAU;

#define RLX_AGENT __ATOMIC_RELAXED, __HIP_MEMORY_SCOPE_AGENT
#define XB_TMO      128
#define XB_XCNT(j)  (256  + 64 * (j))
#define XB_XSUB(j)  (1280 + 64 * (j))
#define XB_XGEN(j)  (2304 + 64 * (j))
#define XB_TOP      3328
#define XB_TOPGEN   3392
#define XCD_BAR_WORDS 3456
#define XB_SPIN_CAP (1u << 18)

__device__ __forceinline__ unsigned xb_ld(unsigned* p)              { return __hip_atomic_load(p, __ATOMIC_RELAXED, __HIP_MEMORY_SCOPE_AGENT); }
__device__ __forceinline__ unsigned xb_add(unsigned* p, unsigned v) { return __hip_atomic_fetch_add(p, v, __ATOMIC_RELAXED, __HIP_MEMORY_SCOPE_AGENT); }
__device__ __forceinline__ unsigned xb_xcc_id() { return (unsigned)__builtin_amdgcn_s_getreg((3 << 11) | 20) & 0xFu; }
#define XB_SPIN(cond, bar) do { unsigned _sp = 0; while (cond) { __builtin_amdgcn_s_sleep(1); \
    if ((++_sp & 255u) == 0u) { if (xb_ld(&(bar)[XB_TMO])) break; if (_sp > XB_SPIN_CAP) { atomicAdd(&(bar)[XB_TMO], 1u); break; } } } } while (0)

struct XcdBarrier {
    unsigned* bar; unsigned x;
    volatile LAS unsigned* st;
};

__device__ __forceinline__ XcdBarrier xcd_barrier_post(unsigned* bar, volatile LAS unsigned* st) {
    XcdBarrier b; b.bar = bar; b.x = xb_xcc_id(); b.st = st;
    if (threadIdx.x == 0) (void)xb_add(&bar[XB_XCNT(b.x)], 1u);
    return b;
}
__device__ __forceinline__ void xcd_barrier_complete(unsigned* bar, unsigned x, unsigned& nloc, unsigned& nx) {
    const unsigned G = gridDim.x * gridDim.y * gridDim.z;
    unsigned sum, cnt, mine, sp = 0u;
    for (;;) {
        sum = 0u; cnt = 0u; mine = 0u;
#pragma unroll
        for (unsigned j = 0; j < 16; ++j) { const unsigned c = xb_ld(&bar[XB_XCNT(j)]); sum += c; cnt += (c > 0u) ? 1u : 0u; mine = (j == x) ? c : mine; }
        if (sum == G) break;
        __builtin_amdgcn_s_sleep(1);
        if ((++sp & 255u) == 0u) { if (xb_ld(&bar[XB_TMO])) break; if (sp > XB_SPIN_CAP) { atomicAdd(&bar[XB_TMO], 1u); break; } }
    }
    nloc = mine > 0u ? mine : 1u; nx = cnt > 0u ? cnt : 1u;
}

__device__ __forceinline__ void xcd_barrier(const XcdBarrier& b) {
    asm volatile("s_waitcnt vmcnt(0)" ::: "memory");
    __syncthreads();
    if (threadIdx.x == 0) {
        unsigned* bar = b.bar;
        __builtin_amdgcn_s_waitcnt(0);
        unsigned nloc = b.st[0], nx = b.st[1];
        if (nloc == 0u) { xcd_barrier_complete(bar, b.x, nloc, nx); b.st[0] = nloc; b.st[1] = nx; }
        const unsigned old = xb_add(&bar[XB_XSUB(b.x)], 1u);
        const unsigned gen = old / nloc;
        if (old + 1u == (gen + 1u) * nloc) {
            __builtin_amdgcn_fence(__ATOMIC_RELEASE, "agent");
            asm volatile("s_waitcnt vmcnt(0)" ::: "memory");
            const unsigned og = xb_add(&bar[XB_TOP], 1u);
            const unsigned tg = og / nx;
            if (og + 1u == (tg + 1u) * nx) xb_add(&bar[XB_TOPGEN], 1u);
            else XB_SPIN(xb_ld(&bar[XB_TOPGEN]) == tg, bar);
            __builtin_amdgcn_fence(__ATOMIC_ACQUIRE, "agent");
            xb_add(&bar[XB_XGEN(b.x)], 1u);
            asm volatile("s_waitcnt vmcnt(0)" ::: "memory");
        } else {
            XB_SPIN(xb_ld(&bar[XB_XGEN(b.x)]) == gen, bar);
            __builtin_amdgcn_fence(__ATOMIC_ACQUIRE, "agent");
            asm volatile("s_waitcnt vmcnt(0)" ::: "memory");
        }
    }
    __syncthreads();
}


__device__ __forceinline__ void grid_bar(unsigned* cnt, unsigned target) {
    asm volatile("s_waitcnt vmcnt(0)" ::: "memory");
    __syncthreads();
    if (tid_fresh() == 0) {
        __builtin_amdgcn_fence(__ATOMIC_RELEASE, "agent");
        asm volatile("s_waitcnt vmcnt(0)" ::: "memory");
        __hip_atomic_fetch_add(cnt, 1u, __ATOMIC_RELAXED, __HIP_MEMORY_SCOPE_AGENT);
        while (__hip_atomic_load(cnt, __ATOMIC_RELAXED, __HIP_MEMORY_SCOPE_AGENT) < target) __builtin_amdgcn_s_sleep(1);
        __builtin_amdgcn_fence(__ATOMIC_ACQUIRE, "agent");
        asm volatile("s_waitcnt vmcnt(0)" ::: "memory");
    }
    __syncthreads();
}

#define TID_VARS() const int tid = tid_fresh(), lane = tid & 63, wave = __builtin_amdgcn_readfirstlane(tid >> 6); const int gw = bx * 8 + wave, NGW = G * 8; (void)lane; (void)gw; (void)NGW; (void)tid;
#define WS_PTRS() \
    unsigned char* ws = args.ws; asm volatile("" : "+s"(ws)); \
    unsigned* ctl = (unsigned*)(ws + WS_CTL); (void)ctl; \
    float* XS = (float*)(ws + WS_XS); bf16_t* HB = (bf16_t*)(ws + WS_HB); (void)XS; (void)HB; \
    bf16_t* WIN = (bf16_t*)(ws + WS_WIN); bf16_t* WM = (bf16_t*)(ws + WS_WM); bf16_t* WO = (bf16_t*)(ws + WS_WO); bf16_t* PWT = (bf16_t*)(ws + WS_PW); (void)WIN; (void)WM; (void)WO; (void)PWT; \
    bf16_t* QB = (bf16_t*)(ws + WS_QB); bf16_t* KB = (bf16_t*)(ws + WS_KB); bf16_t* VB = (bf16_t*)(ws + WS_VB); bf16_t* UB = (bf16_t*)(ws + WS_UB); (void)QB; (void)KB; (void)VB; (void)UB; \
    bf16_t* GA = (bf16_t*)(ws + WS_GA); bf16_t* GP = (bf16_t*)(ws + WS_GP); bf16_t* SMA = (bf16_t*)(ws + WS_SMA); bf16_t* SMP = (bf16_t*)(ws + WS_SMP); (void)GA; (void)GP; (void)SMA; (void)SMP; \
    bf16_t* OAP = (bf16_t*)(ws + WS_OAP); bf16_t* PL = (bf16_t*)(ws + WS_PL); float* T1 = (float*)(ws + WS_T1); bf16_t* MG = (bf16_t*)(ws + WS_MG); (void)OAP; (void)PL; (void)T1; (void)MG;
#define IN(k) (lo <= (k) && (k) < hi)
#if MK_MULTI
#define SEAM(k) do { } while (0)
#else
#ifdef PROBE_SEL
#define STAMP(k) do { if (bx == 0 && tid_fresh() == 0) ((unsigned long long*)(args.ws + WS_CTL + 2048))[(k)] = __builtin_amdgcn_s_memrealtime(); } while (0)
#else
#define STAMP(k) do { } while (0)
#endif
#define SEAM(k) do { if (IN(k) && IN((k) + 1)) { unsigned char* wsb = args.ws; asm volatile("" : "+s"(wsb)); ++nbar; xcd_barrier(xbar); STAMP((k) + 1); } } while (0)
#endif

template <int L, int COFF>
__device__ __forceinline__ void layer_phases(const Args& args, LAS unsigned char* lds, const int G, const int bx, const int lo, const int hi, unsigned& nbar, const XcdBarrier& xbar) {
    constexpr int P0 = 1 + 5 * L;
    if (IN(P0 + 1)) {
        WS_PTRS();
#ifndef DIS_A
        for (int rep = 0; rep < REP_A; ++rep) {
        pg8::Gemm g{HB, WIN + (size_t)L * INC * DM}; pg8::StaticOrder S; S.init(MREAL, INC, G, bx);
        EpiIn E{ws, (const float*)(ws + WS_SSQ) + (size_t)L * MPAD * SSQ_STRIDE};
        pg8::gemm_phase<EpiIn, pg8::StaticOrder, DM, DM, DM>(lds, g, S, E);
        }
#endif
        { TID_VARS(); skinny_in(lds, ws, WIN + (size_t)L * INC * DM, (const float*)(ws + WS_SSQ) + (size_t)L * MPAD * SSQ_STRIDE, bx, G, wave, lane); }
    }
    SEAM(P0 + 1);
    if (IN(P0 + 2)) {
        WS_PTRS();
        LAS volatile int* item_s = (LAS volatile int*)(lds + MISC_OFF);
        for (int rep = 0; rep < REP_B; ++rep) {
            unsigned* ctr = ctl + L + 8 * rep + COFF;
            __syncthreads();
            if (tid_fresh() == 0) item_s[0] = (int)atomicAdd(ctr, 1u);
            __syncthreads();
            int item = __builtin_amdgcn_readfirstlane(item_s[0]);
            int par = 1;
            while (item < N_BITEMS) {
                int nxt = 0; if (tid_fresh() == 0) nxt = (int)atomicAdd(ctr, 1u);
#ifndef DIS_B
                if (L + 1 == DEPTH && (item >= N_POOLU + N_ATT || (item >> 2) == 32)) {
                } else if (item >= N_POOLU) {
                    const int ia = item - N_POOLU;
                    const int qb = ia < N_ATT ? 15 - ia / 32 : -1, bh = ia < N_ATT ? ia % 32 : ia - N_ATT;
                    attn_unit(lds, QB, KB, VB, GA, OAP, bh >> 3, bh & 7, qb);
                } else {
                    pool_unit(lds, UB, PL, PWT + (size_t)L * 4 * GD * GD, args.pool_scale + (size_t)L * PWD, GP, OAP, item >> 2, item & 3);
                }
#endif
                if (tid_fresh() == 0) item_s[par] = nxt;
                __syncthreads();
                item = __builtin_amdgcn_readfirstlane(item_s[par]);
                par ^= 1;
            }
        }
    }
    SEAM(P0 + 2);
    if (IN(P0 + 3)) {
        WS_PTRS();
        pg8::StaticOrder S; S.init(MREAL, DM, G, bx);
#ifndef DIS_C
        for (int rep = 0; rep < REP_C; ++rep) {
        { pg8::Gemm g{OAP, WM + (size_t)L * DM * DM}; EpiMerge E{SMA, SMP, MG}; pg8::gemm_phase<EpiMerge, pg8::StaticOrder, DM, DM, DM>(lds, g, S, E); }
        }
#endif
        if (L + 1 < DEPTH) { TID_VARS(); skinny_merge(lds, ws, WM + (size_t)L * DM * DM, bx, G, wave, lane); }
    }
    SEAM(P0 + 3);
    if (IN(P0 + 4)) {
        WS_PTRS();
#ifndef DIS_D
        pg8::Gemm g{MG, WO + (size_t)L * DM * DM}; pg8::StaticOrder S; S.init(MREAL, DM, G, bx);
        if (L == DEPTH - 1 && G >= (MREAL / 256) * (DM / 256)) {
            EpiResFinal E{(const float*)XS, args.final_gain, args.out, (float*)(ws + WS_SSQ) + (size_t)(L + 1) * MPAD * SSQ_STRIDE, (unsigned*)(ws + WS_BAR) + XCD_BAR_WORDS};
            pg8::gemm_phase<EpiResFinal, pg8::StaticOrder, DM, DM, DM>(lds, g, S, E);
        } else {
        EpiRes E{L == 0 ? args.x : (const float*)XS, XS, L == DEPTH - 1 ? (bf16_t*)nullptr : HB, (float*)(ws + WS_SSQ) + (size_t)(L + 1) * MPAD * SSQ_STRIDE};
        pg8::gemm_phase<EpiRes, pg8::StaticOrder, DM, DM, DM>(lds, g, S, E);
        }
#endif
        if (L + 1 < DEPTH) { TID_VARS(); skinny_out(lds, ws, WO + (size_t)L * DM * DM, L == 0 ? args.meta : (const float*)(XS + (size_t)MREAL * DM), (float*)(ws + WS_SSQ) + (size_t)(L + 1) * MPAD * SSQ_STRIDE, bx, G, wave, lane); }
    }
    if (!(L == DEPTH - 1 && G >= (MREAL / 256) * (DM / 256))) SEAM(P0 + 4);
}

template <int COFF>
__device__ __forceinline__ void run_all(const Args& args, LAS unsigned char* lds, const int G, const int bx, const int lo, const int hi, unsigned& nbar, const XcdBarrier& xbar) {
    if (IN(PH_PRO)) {
        WS_PTRS(); TID_VARS();
#ifndef DIS_PRO
        for (int rep = 0; rep < REP_PRO; ++rep) {
        LAS float* scr = (LAS float*)(lds + wave * 8704);
        constexpr int I_IN = 32 * 320, I_UP = 16 * 64, I_OUT = 32 * 64, I_PW = 4 * 8;
        constexpr int PER_L = I_IN + 2 * I_UP + I_OUT + 4 * I_PW;
        for (int it = gw; it < DEPTH * PER_L; it += NGW) {
            const int L = it / PER_L; int r = it % PER_L;
            if (r < I_IN) { transpose_item(args.w_in + (size_t)L * DM * INC, INC, WIN + (size_t)L * INC * DM, DM, 0, scr, r / 320, r % 320, lane, args.norm_gain + (size_t)L * DM); continue; } r -= I_IN;
            if (r < I_UP) { transpose_item(args.w_attn_up + (size_t)L * SBW * DM, DM, WM + (size_t)L * DM * DM, DM, 0, scr, r / 64, r % 64, lane); continue; } r -= I_UP;
            if (r < I_UP) { transpose_item(args.w_pool_up + (size_t)L * PWD * DM, DM, WM + (size_t)L * DM * DM, DM, 1024, scr, r / 64, r % 64, lane); continue; } r -= I_UP;
            if (r < I_OUT) { transpose_item(args.w_out + (size_t)L * DM * DM, DM, WO + (size_t)L * DM * DM, DM, 0, scr, r / 64, r % 64, lane); continue; } r -= I_OUT;
            { const int gq = r / I_PW, rr = r % I_PW; transpose_item(args.pool_w + ((size_t)L * 4 + gq) * GD * GD, GD, PWT + ((size_t)L * 4 + gq) * GD * GD, GD, 0, scr, rr / 8, rr % 8, lane); }
        }
        }
#endif
        for (int m = gw; m < MROWS; m += NGW) {
            const float* src = (m < MREAL) ? args.x + (size_t)m * DM : args.meta + (size_t)(m - MREAL) * DM;
            init_row(src, HB + (size_t)m * DM, (float*)(ws + WS_SSQ) + (size_t)m * SSQ_STRIDE, lane);
        }
        { unsigned zu = 0u; asm volatile("" : "+v"(zu)); const int gt = bx * 512 + tid, NGT = G * 512; constexpr int PIECES = NB * TOFF * 128;
          for (int p = gt; p < 3 * PIECES; p += NGT) { const int bufi = p / PIECES, q = p % PIECES, bb = q / (TOFF * 128), rem = q % (TOFF * 128);
              bf16_t* base = bufi == 0 ? KB : (bufi == 1 ? VB : UB);
              *(u32x4*)(base + (size_t)bb * LP * 1024 + (size_t)rem * 8) = (u32x4){zu, zu, zu, zu}; } }
    }
    SEAM(PH_PRO);
    layer_phases<0, COFF>(args, lds, G, bx, lo, hi, nbar, xbar);
    layer_phases<1, COFF>(args, lds, G, bx, lo, hi, nbar, xbar);
    layer_phases<2, COFF>(args, lds, G, bx, lo, hi, nbar, xbar);
    layer_phases<3, COFF>(args, lds, G, bx, lo, hi, nbar, xbar);
    if (IN(PH_FINAL) && G < (MREAL / 256) * (DM / 256)) {
        WS_PTRS(); TID_VARS();
        for (int m = gw; m < MREAL; m += NGW) final_row(XS + (size_t)m * DM, args.final_gain, args.out + (size_t)m * DM, ((const float*)(ws + WS_SSQ))[((size_t)DEPTH * MPAD + m) * SSQ_STRIDE], lane);
    }
}

__global__ void __launch_bounds__(512, 2) mega_fwd(Args args) {
    extern __shared__ __attribute__((aligned(16))) unsigned char lds_raw[];
    LAS unsigned char* lds = (LAS unsigned char*)lds_raw;
    cg::grid_group grid = cg::this_grid();
    const int G = gridDim.x, bx = blockIdx.x;
    const int lo = args.ph_lo, hi = args.ph_hi;
    if (hi < 0) grid.sync();
    unsigned nbar = 0;
    { LAS unsigned* mw = (LAS unsigned*)(lds + MISC_OFF + 256); if (tid_fresh() < 4) mw[tid_fresh()] = 0u; __syncthreads(); }
    const XcdBarrier xbar = xcd_barrier_post((unsigned*)(args.ws + WS_BAR), (volatile LAS unsigned*)(lds + MISC_OFF + 256));
    STAMP(0);
    run_all<0>(args, lds, G, bx, lo, hi, nbar, xbar);
#ifdef PROBE_SEL
    if (bx == 0) { __syncthreads(); if (tid_fresh() == 0) {
        const unsigned long long* st = (const unsigned long long*)(args.ws + WS_CTL + 2048);
        const unsigned long long tend = __builtin_amdgcn_s_memrealtime();
        float v = 0.f;
        if (PROBE_SEL == 0) v = (float)(st[1] - st[0]) * 0.01f;
        else if (PROBE_SEL >= 1 && PROBE_SEL <= 5) { unsigned long long acc = 0; for (int L = 0; L < 4; ++L) acc += st[1 + 5 * L + PROBE_SEL] - st[5 * L + PROBE_SEL]; v = (float)acc * 0.01f * 0.25f; }
        else if (PROBE_SEL == 6) v = (float)(tend - st[21]) * 0.01f;
        else v = (float)(tend - st[0]) * 0.01f * 0.1f;
        args.out[0] = v; } }
#endif
#ifdef PROBE_TWICE
    { unsigned char* wsb = args.ws; asm volatile("" : "+s"(wsb)); ++nbar; grid_bar((unsigned*)(wsb + WS_CTL) + 128, nbar * (unsigned)G); }
    run_all<32>(args, lds, G, bx, lo, hi, nbar, xbar);
#endif
}

extern "C" void kernel_launch(void* const* d_in, const int* in_sizes, int n_in, void* d_out, int out_size, void* d_ws, size_t ws_size, hipStream_t stream) {
    static int grid = 0;
    if (grid == 0) {
        if (n_in != 10 || ws_size < WS_END) { fprintf(stderr, "kernel_launch: need 10 inputs and >= %zu bytes of workspace (got %d, %zu)\n", (size_t)WS_END, n_in, ws_size); grid = -1; return; }
        int dev = 0, cus = 0, per_cu = 0;
        hipGetDevice(&dev); hipDeviceGetAttribute(&cus, hipDeviceAttributeMultiprocessorCount, dev);
        if (hipFuncSetAttribute((const void*)mega_fwd, hipFuncAttributeMaxDynamicSharedMemorySize, LDS_BYTES) != hipSuccess) { fprintf(stderr, "kernel_launch: hipFuncSetAttribute failed\n"); grid = -1; return; }
        if (hipOccupancyMaxActiveBlocksPerMultiprocessor(&per_cu, (const void*)mega_fwd, 512, LDS_BYTES) != hipSuccess || per_cu < 1) { fprintf(stderr, "kernel_launch: occupancy query gave %d\n", per_cu); per_cu = 1; }
        (void)hipGetLastError();
        grid = cus * per_cu;
    }
    if (grid < 0) return;
    if (hipMemsetAsync((char*)d_ws + WS_CTL, 0, WS_ZERO_BYTES, stream) != hipSuccess) { fprintf(stderr, "kernel_launch: memset failed\n"); return; }
    Args a{};
    a.x = (const float*)d_in[0]; a.meta = (const float*)d_in[1]; a.norm_gain = (const float*)d_in[2]; a.w_in = (const float*)d_in[3]; a.pool_w = (const float*)d_in[4];
    a.pool_scale = (const float*)d_in[5]; a.w_attn_up = (const float*)d_in[6]; a.w_pool_up = (const float*)d_in[7]; a.w_out = (const float*)d_in[8]; a.final_gain = (const float*)d_in[9];
    a.out = (float*)d_out; a.ws = (unsigned char*)d_ws;
#if MK_MULTI
    for (int ph = 0; ph < N_PHASES; ++ph) {
        if (ph >= 1 && ph < PH_FINAL && (ph - 1) % 5 == 0 && (ph - 1) / 5 == 0) continue;
        a.ph_lo = ph; a.ph_hi = ph + 1;
        hipLaunchKernelGGL(mega_fwd, dim3(grid), dim3(512), LDS_BYTES, stream, a);
    }
#else
    a.ph_lo = 0; a.ph_hi = N_PHASES;
    void* kargs[] = {&a};
    hipError_t e = hipLaunchCooperativeKernel((const void*)mega_fwd, dim3(grid), dim3(512), kargs, LDS_BYTES, stream);
    if (e != hipSuccess) fprintf(stderr, "cooperative launch failed: %s (grid %d)\n", hipGetErrorString(e), grid);
#endif
}
```

```cpp
#include <hip/hip_runtime.h>
#include <hip/hip_cooperative_groups.h>
#include <cstdio>
#include <cstdint>
namespace cg = cooperative_groups;

#ifndef REP_PRO
#define REP_PRO 1
#endif
#ifndef REP_A
#define REP_A 1
#endif
#ifndef REP_B
#define REP_B 1
#endif
#ifndef REP_C
#define REP_C 1
#endif
#ifndef MK_MULTI
#define MK_MULTI 0
#endif

#define LAS __attribute__((address_space(3)))
typedef unsigned short bf16_t;
typedef short bf16x8 __attribute__((ext_vector_type(8)));
typedef short s16x4 __attribute__((ext_vector_type(4)));
typedef float f32x4 __attribute__((ext_vector_type(4)));
typedef unsigned u32x4 __attribute__((ext_vector_type(4)));
typedef unsigned u32x2 __attribute__((ext_vector_type(2)));

constexpr int DM = 2048, NB = 4, SEQ = 2048, DEPTH = 4, NMETA = 16, NH = 8, DH = 128, SBW = 1024, PWD = 1024, GD = 256, INC = 10240;
constexpr int MREAL = NB * SEQ;
constexpr int MROWS = MREAL + NMETA;
constexpr int MPAD = 8448;
constexpr int LP = 2176;
constexpr int TOFF = 48;
constexpr float RMS_EPS = 1e-6f;
constexpr float LOG2E = 1.4426950408889634f;
constexpr float QSCALE = 0.08838834764831845f * LOG2E;

constexpr size_t al256(size_t x) { return (x + 255) & ~(size_t)255; }
constexpr size_t WS_CTL = 0;
constexpr size_t WS_SSQ = 4096;
constexpr int SSQ_STRIDE = 1;
constexpr size_t WS_BAR = WS_SSQ + (size_t)(DEPTH + 1) * MPAD * SSQ_STRIDE * 4;
constexpr size_t WS_ZERO_BYTES = WS_BAR + 16384;
constexpr size_t WS_XS = al256(WS_ZERO_BYTES);
constexpr size_t WS_HB = al256(WS_XS + (size_t)MPAD * DM * 4);
constexpr size_t WS_WIN = al256(WS_HB + (size_t)MPAD * DM * 2);
constexpr size_t WS_WM = al256(WS_WIN + (size_t)DEPTH * INC * DM * 2);
constexpr size_t WS_WO = al256(WS_WM + (size_t)DEPTH * DM * DM * 2);
constexpr size_t WS_PW = al256(WS_WO + (size_t)DEPTH * DM * DM * 2);
constexpr size_t WS_QB = al256(WS_PW + (size_t)DEPTH * 4 * GD * GD * 2);
constexpr size_t WS_KB = al256(WS_QB + (size_t)MPAD * 1024 * 2);
constexpr size_t WS_VB = al256(WS_KB + (size_t)NB * LP * 1024 * 2);
constexpr size_t WS_UB = al256(WS_VB + (size_t)NB * LP * 1024 * 2);
constexpr size_t WS_GA = al256(WS_UB + (size_t)NB * LP * 1024 * 2);
constexpr size_t WS_GP = al256(WS_GA + (size_t)MPAD * 1024 * 2);
constexpr size_t WS_SMA = al256(WS_GP + (size_t)MPAD * 1024 * 2);
constexpr size_t WS_SMP = al256(WS_SMA + (size_t)MPAD * DM * 2);
constexpr size_t WS_OAP = al256(WS_SMP + (size_t)MPAD * DM * 2);
constexpr size_t WS_PL = al256(WS_OAP + (size_t)MPAD * DM * 2);
constexpr size_t WS_T1 = al256(WS_PL + (size_t)MPAD * 1024 * 2);
constexpr size_t WS_MG = al256(WS_T1 + (size_t)MPAD * DM * 4);
constexpr size_t WS_END = al256(WS_MG + (size_t)MPAD * DM * 2);

constexpr int LDS_BYTES = 147456;
constexpr int RING_BYTES = 131072;
constexpr int MISC_OFF = RING_BYTES;

__device__ __forceinline__ unsigned cvt_pk_bf16(float lo, float hi) { unsigned r; asm volatile("v_cvt_pk_bf16_f32 %0, %1, %2" : "=v"(r) : "v"(lo), "v"(hi)); return r; }
__device__ __forceinline__ int tid_fresh() { int t = threadIdx.x; asm volatile("" : "+v"(t)); return t; }
__device__ __forceinline__ const char* uni_ptr(const char* p) {
    const unsigned long long v = (unsigned long long)p;
    const unsigned lo = __builtin_amdgcn_readfirstlane((unsigned)v), hi = __builtin_amdgcn_readfirstlane((unsigned)(v >> 32));
    return (const char*)(((unsigned long long)hi << 32) | lo);
}
__device__ __forceinline__ float bf_lo(unsigned w) { return __uint_as_float(w << 16); }
__device__ __forceinline__ float bf_hi(unsigned w) { return __uint_as_float(w & 0xffff0000u); }
__device__ __forceinline__ float fsigmoid(float v) { return __builtin_amdgcn_rcpf(1.0f + __builtin_amdgcn_exp2f(-v * LOG2E)); }
__device__ __forceinline__ float shfl_idx(float v, int srclane) { return __int_as_float(__builtin_amdgcn_ds_bpermute(srclane << 2, __float_as_int(v))); }
__device__ __forceinline__ float wave_sum(float v, int lane) {
#pragma unroll
    for (int o = 1; o < 64; o <<= 1) v += shfl_idx(v, lane ^ o);
    return v;
}
__device__ __forceinline__ int btrow(int row) {
    return (row >> 11) * LP + 64 + (row & 2047);
}

namespace pg8 {
constexpr int BM = 256, BK = 64, HALF = 128, HTB = HALF * BK * 2, STAGE_BYTES = 8 * HTB, NXCD = 8, WGM = 8;
__host__ __device__ __forceinline__ int lds_byte(int r, int c) { const int st = (r >> 4) * 2 + (c >> 5), rr = r & 15, cc = c & 31, ob = rr * 64 + cc * 2; return st * 1024 + (ob ^ (((ob >> 9) & 1) << 5)); }
__host__ __device__ __forceinline__ void stage_rc(int b, int& R, int& C) { const int st = b / 1024, sb = b % 1024, swz = sb ^ (((sb >> 9) & 1) << 5); R = (st >> 1) * 16 + swz / 64; C = (st & 1) * 32 + (swz % 64) / 2; }
__host__ __device__ __forceinline__ int perm32(int rho) { const int n = rho >> 4, i = rho & 15; return 8 * (i >> 2) + 4 * n + (i & 3); }

struct Unit { int pm, pn; };
struct Gemm { const bf16_t* A; const bf16_t* Bt; };

struct StaticOrder {
    int nM, nN, nwg, G, c;
    __host__ __device__ void init(int M, int N, int G_, int c_) { nM = M / BM; nN = N / BM; nwg = nM * nN; G = G_; c = c_; }
    __host__ __device__ bool next(int i, Unit& u) const {
        const long L = (long)i * G + c; if (L >= nwg) return false;
        int wgid = (int)L; { const int q = nwg / NXCD, r = nwg % NXCD, xcd = wgid % NXCD, off = wgid / NXCD; wgid = (xcd < r ? xcd * (q + 1) : r * (q + 1) + (xcd - r) * q) + off; }
        const int nig = WGM * nN, gid = wgid / nig, fm = gid * WGM, gsz = (nM - fm) < WGM ? (nM - fm) : WGM;
        u.pm = fm + ((wgid % nig) % gsz); u.pn = (wgid % nig) / gsz; return true;
    }
};
struct OneUnit {
    Unit u;
    __device__ bool next(int i, Unit& o) const { if (i) return false; o = u; return true; }
};

template <class Epi, class Sched, int LDA, int LDB, int KK, bool ALIGN_EPI = true, bool SP2 = true>
__device__ __forceinline__ void gemm_phase(LAS unsigned char* lds, const Gemm g, const Sched& S, const Epi& E) {
    const int tid = tid_fresh(), wid = __builtin_amdgcn_readfirstlane(tid >> 6), lane = tid & 63, wr = wid >> 2, wc = wid & 3, fr = lane & 15, fq = lane >> 4;
    constexpr int nt = KK / BK;
    unsigned voffA[2], voffB[2];
#pragma unroll
    for (int i = 0; i < 2; ++i) { int R, C; stage_rc(tid * 16 + i * 8192, R, C); const int Rb = Epi::PERM ? ((R & ~31) + perm32(R & 31)) : R;
        voffA[i] = (unsigned)(R * LDA + C) * 2u; voffB[i] = (unsigned)(Rb * LDB + C) * 2u; }
    constexpr size_t kstep = (size_t)(BK * 2);
    constexpr size_t hstepA = (size_t)HALF * LDA * 2, hstepB = (size_t)HALF * LDB * 2;
    constexpr size_t tstepA = 2 * hstepA, tstepB = 2 * hstepB;
    const unsigned ldsw = (unsigned)wid * 1024u;
    const unsigned ldsbase = (unsigned)(size_t)lds + ldsw;
    const int aoff = lds_byte(wr * 64 + fr, fq * 8), boff = lds_byte(wc * 32 + fr, fq * 8);
#define PG8_SA(b, h) (((b) * 2 + (h)) * HTB)
#define PG8_SB(b, h) ((4 + (b) * 2 + (h)) * HTB)
#define PG8_STAGE(bufoff, gbase, voff) do { _Pragma("unroll") for (int _i = 0; _i < 2; ++_i) \
        asm volatile("s_mov_b32 m0, %2\n\ts_nop 0\n\tglobal_load_lds_dwordx4 %0, %1" :: "v"((voff)[_i]), "s"(uni_ptr((const char*)(gbase))), "s"(ldsbase + (unsigned)((bufoff) + _i * 8192)) : "memory", "m0"); } while (0)
#define PG8_LDA(dst, b, h) do { _Pragma("unroll") for (int m = 0; m < 4; ++m) _Pragma("unroll") for (int k = 0; k < 2; ++k) dst[m][k] = *(const LAS bf16x8*)(lds + PG8_SA(b, h) + aoff + m * 2048 + k * 1024); } while (0)
#define PG8_LDB(dst, b, h) do { _Pragma("unroll") for (int n = 0; n < 2; ++n) _Pragma("unroll") for (int k = 0; k < 2; ++k) dst[n][k] = *(const LAS bf16x8*)(lds + PG8_SB(b, h) + boff + n * 2048 + k * 1024); } while (0)
#define PG8_MMA(ai, bj, At, Bt) do { __builtin_amdgcn_s_setprio(1); _Pragma("unroll") for (int m = 0; m < 4; ++m) _Pragma("unroll") for (int n = 0; n < 2; ++n) _Pragma("unroll") for (int k = 0; k < 2; ++k) \
        acc[ai][bj][m][n] = __builtin_amdgcn_mfma_f32_16x16x32_bf16(Bt[n][k], At[m][k], acc[ai][bj][m][n], 0, 0, 0); __builtin_amdgcn_s_setprio(0); } while (0)
#define PG8_WAIT_V(n) asm volatile("s_waitcnt vmcnt(" #n ")" ::: "memory")
#define PG8_WAIT_L(n) asm volatile("s_waitcnt lgkmcnt(" #n ")" ::: "memory")
#define PG8_BAR __builtin_amdgcn_s_barrier()
#define PG8_SCHED __builtin_amdgcn_sched_barrier(0)
    Unit cur, nxt; int ui = 0;
    if (!S.next(0, cur)) return;
    f32x4 acc[2][2][4][2];
#pragma unroll
    for (int a = 0; a < 2; ++a)
#pragma unroll
        for (int b = 0; b < 2; ++b)
#pragma unroll
            for (int m = 0; m < 4; ++m)
#pragma unroll
                for (int n = 0; n < 2; ++n) acc[a][b][m][n] = (f32x4){0.f, 0.f, 0.f, 0.f};
    bf16x8 At[4][2], B0[2][2], B1[2][2];
    const char* cA = (const char*)g.A + (size_t)cur.pm * tstepA; const char* cB = (const char*)g.Bt + (size_t)cur.pn * tstepB;
    if constexpr (SP2) {
        PG8_STAGE(PG8_SB(0, 0), cB, voffB); PG8_STAGE(PG8_SB(0, 1), cB + hstepB, voffB); PG8_STAGE(PG8_SA(0, 0), cA, voffA); PG8_STAGE(PG8_SA(0, 1), cA + hstepA, voffA);
        if (wr == 1) PG8_BAR;
        PG8_WAIT_V(2); PG8_BAR;
        PG8_STAGE(PG8_SB(1, 0), cB + kstep, voffB); PG8_STAGE(PG8_SA(1, 0), cA + kstep, voffA); PG8_STAGE(PG8_SB(1, 1), cB + hstepB + kstep, voffB);
        PG8_WAIT_V(6); PG8_BAR;
    } else {
        PG8_STAGE(PG8_SB(0, 0), cB, voffB); PG8_STAGE(PG8_SA(0, 0), cA, voffA); PG8_STAGE(PG8_SB(0, 1), cB + hstepB, voffB); PG8_STAGE(PG8_SA(0, 1), cA + hstepA, voffA);
        if (wr == 1) PG8_BAR;
        PG8_WAIT_V(4); PG8_BAR;
        PG8_STAGE(PG8_SB(1, 0), cB + kstep, voffB); PG8_STAGE(PG8_SA(1, 0), cA + kstep, voffA); PG8_STAGE(PG8_SB(1, 1), cB + hstepB + kstep, voffB);
        PG8_WAIT_V(6); PG8_BAR;
    }
    for (;;) {
        const bool has_next = S.next(ui + 1, nxt);
        const char* nA = has_next ? (const char*)g.A + (size_t)nxt.pm * tstepA : cA; const char* nB = has_next ? (const char*)g.Bt + (size_t)nxt.pn * tstepB : cB;
#pragma unroll 1
        for (int kh = 0; kh < (Epi::MID ? 2 : 1); ++kh) {
        if constexpr (Epi::MID) { if (kh == 1) E.mid(acc, cur, wr, wc, fr, fq); }
        const int t_end = Epi::MID ? (kh + 1) * (nt / 2) : nt;
#pragma unroll 1
        for (int t = Epi::MID ? kh * (nt / 2) : 0; t < t_end; t += 2) {
            const bool last = (t == nt - 2);
            const char* a1 = cA + (size_t)(t + 1) * kstep;
            const char* a2 = last ? nA : cA + (size_t)(t + 2) * kstep; const char* b2 = last ? nB : cB + (size_t)(t + 2) * kstep;
            const char* a3 = a2 + kstep; const char* b3 = b2 + kstep;
            if constexpr (SP2) {
            PG8_LDB(B0, 0, 0); PG8_LDB(B1, 0, 1); PG8_SCHED; PG8_LDA(At, 0, 0); PG8_STAGE(PG8_SA(1, 1), a1 + hstepA, voffA);
            PG8_WAIT_V(8); PG8_WAIT_L(0); PG8_BAR; PG8_MMA(0, 0, At, B0); PG8_MMA(0, 1, At, B1); PG8_BAR; PG8_SCHED;
            PG8_LDA(At, 0, 1); PG8_STAGE(PG8_SB(0, 0), b2, voffB); PG8_STAGE(PG8_SB(0, 1), b2 + hstepB, voffB); PG8_STAGE(PG8_SA(0, 0), a2, voffA);
            PG8_WAIT_V(8); PG8_WAIT_L(0); PG8_BAR; PG8_MMA(1, 0, At, B0); PG8_MMA(1, 1, At, B1); PG8_BAR; PG8_SCHED;
            PG8_LDB(B0, 1, 0); PG8_LDB(B1, 1, 1); PG8_SCHED; PG8_LDA(At, 1, 0); PG8_STAGE(PG8_SA(0, 1), a2 + hstepA, voffA);
            PG8_WAIT_V(8); PG8_WAIT_L(0); PG8_BAR; PG8_MMA(0, 0, At, B0); PG8_MMA(0, 1, At, B1); PG8_BAR; PG8_SCHED;
            PG8_LDA(At, 1, 1); PG8_STAGE(PG8_SB(1, 0), b3, voffB); PG8_STAGE(PG8_SB(1, 1), b3 + hstepB, voffB); PG8_STAGE(PG8_SA(1, 0), a3, voffA);
            PG8_WAIT_V(8); PG8_WAIT_L(0); PG8_BAR; PG8_MMA(1, 0, At, B0); PG8_MMA(1, 1, At, B1); PG8_BAR; PG8_SCHED;
            } else {
            PG8_LDB(B0, 0, 0); PG8_SCHED; PG8_LDA(At, 0, 0); PG8_STAGE(PG8_SA(1, 1), a1 + hstepA, voffA);
            PG8_WAIT_L(8); PG8_BAR; PG8_WAIT_L(0); PG8_MMA(0, 0, At, B0); PG8_BAR; PG8_SCHED;
            PG8_LDB(B1, 0, 1); PG8_STAGE(PG8_SB(0, 0), b2, voffB);
            PG8_BAR; PG8_WAIT_L(0); PG8_MMA(0, 1, At, B1); PG8_BAR;
            PG8_LDA(At, 0, 1); PG8_STAGE(PG8_SA(0, 0), a2, voffA);
            PG8_BAR; PG8_WAIT_L(0); PG8_MMA(1, 0, At, B0); PG8_BAR; PG8_SCHED;
            PG8_STAGE(PG8_SB(0, 1), b2 + hstepB, voffB);
            PG8_WAIT_V(6); PG8_BAR; PG8_MMA(1, 1, At, B1); PG8_BAR;
            PG8_LDB(B0, 1, 0); PG8_SCHED; PG8_LDA(At, 1, 0); PG8_STAGE(PG8_SA(0, 1), a2 + hstepA, voffA);
            PG8_WAIT_L(8); PG8_BAR; PG8_WAIT_L(0); PG8_MMA(0, 0, At, B0); PG8_BAR; PG8_SCHED;
            PG8_LDB(B1, 1, 1); PG8_STAGE(PG8_SB(1, 0), b3, voffB);
            PG8_BAR; PG8_WAIT_L(0); PG8_MMA(0, 1, At, B1); PG8_BAR;
            PG8_LDA(At, 1, 1); PG8_STAGE(PG8_SA(1, 0), a3, voffA);
            PG8_BAR; PG8_WAIT_L(0); PG8_MMA(1, 0, At, B0); PG8_BAR; PG8_SCHED;
            PG8_STAGE(PG8_SB(1, 1), b3 + hstepB, voffB);
            PG8_WAIT_V(6); PG8_BAR; PG8_MMA(1, 1, At, B1); PG8_BAR;
            }
        }
        }
        if constexpr (ALIGN_EPI) { if (wr == 0) PG8_BAR; }
        E(acc, cur, wr, wc, fr, fq);
        if (!has_next) break;
#pragma unroll
        for (int a = 0; a < 2; ++a)
#pragma unroll
            for (int b = 0; b < 2; ++b)
#pragma unroll
                for (int m = 0; m < 4; ++m)
#pragma unroll
                    for (int n = 0; n < 2; ++n) acc[a][b][m][n] = (f32x4){0.f, 0.f, 0.f, 0.f};
        cur = nxt; cA = nA; cB = nB; ++ui;
        if constexpr (ALIGN_EPI) { if (wr == 1) PG8_BAR; }
    }
    PG8_WAIT_V(0);
    if constexpr (!ALIGN_EPI) { if (wr == 0) PG8_BAR; }
    PG8_BAR;
#undef PG8_SA
#undef PG8_SB
#undef PG8_STAGE
#undef PG8_LDA
#undef PG8_LDB
#undef PG8_MMA
#undef PG8_WAIT_V
#undef PG8_WAIT_L
#undef PG8_BAR
#undef PG8_SCHED
}
}

using pg8::Unit;
struct EpiIn {
    static constexpr bool PERM = true, MID = false;
    unsigned char* ws; const float* ssq;
    __device__ __forceinline__ void operator()(const f32x4 (&acc)[2][2][4][2], const Unit& u, int wr, int wc, int fr, int fq) const {
        const int pn = u.pn; int mode, ld = 1024, cb; size_t boff; bool bt = false;
        if (pn < 4)       { mode = 0; boff = WS_QB; cb = pn * 256; }
        else if (pn < 8)  { mode = 1; boff = WS_KB; cb = (pn - 4) * 256; bt = true; }
        else if (pn < 12) { mode = 1; boff = WS_VB; cb = (pn - 8) * 256; bt = true; }
        else if (pn < 16) { mode = 2; boff = WS_GA; cb = (pn - 12) * 256; }
        else if (pn < 20) { mode = 1; boff = WS_UB; cb = (pn - 16) * 256; bt = true; }
        else if (pn < 24) { mode = 2; boff = WS_GP; cb = (pn - 20) * 256; }
        else if (pn < 32) { mode = 3; boff = WS_SMA; cb = (pn - 24) * 256; ld = 2048; }
        else              { mode = 3; boff = WS_SMP; cb = (pn - 32) * 256; ld = 2048; }
        const int col0 = cb + wc * 32 + 8 * fq;
        float rsv[8];
#pragma unroll
        for (int it = 0; it < 8; ++it) rsv[it] = ssq[(size_t)(u.pm * 256 + (it >> 2) * 128 + wr * 64 + (it & 3) * 16 + fr) * SSQ_STRIDE];
#pragma unroll
        for (int it = 0; it < 8; ++it) rsv[it] = __builtin_amdgcn_rsqf(rsv[it] * (1.0f / DM) + RMS_EPS);
#pragma unroll
        for (int ai = 0; ai < 2; ++ai)
#pragma unroll
            for (int m = 0; m < 4; ++m) {
                const int row = u.pm * 256 + ai * 128 + wr * 64 + m * 16 + fr;
                {
                    const float rs = rsv[ai * 4 + m];
                    const int drow = bt ? btrow(row) : row;
                    bf16_t* rowp = (bf16_t*)(ws + boff) + (size_t)drow * ld + col0;
#pragma unroll
                    for (int bj = 0; bj < 2; ++bj) {
                        f32x4 v0 = acc[ai][bj][m][0] * rs, v1 = acc[ai][bj][m][1] * rs;
                        if (mode == 0) { v0 = v0 * QSCALE; v1 = v1 * QSCALE; }
                        else if (mode == 2) {
#pragma unroll
                            for (int e = 0; e < 4; ++e) { v0[e] = v0[e] * fsigmoid(v0[e]); v1[e] = v1[e] * fsigmoid(v1[e]); }
                        } else if (mode == 3) {
#pragma unroll
                            for (int e = 0; e < 4; ++e) { v0[e] = fsigmoid(v0[e]); v1[e] = fsigmoid(v1[e]); }
                        }
                        u32x4 w; w.x = cvt_pk_bf16(v0[0], v0[1]); w.y = cvt_pk_bf16(v0[2], v0[3]); w.z = cvt_pk_bf16(v1[0], v1[1]); w.w = cvt_pk_bf16(v1[2], v1[3]);
                        *(u32x4*)(rowp + bj * 128) = w;
                    }
                }
                asm volatile("" ::: "memory");
            }
    }
};
struct EpiPool {
    static constexpr bool PERM = true, MID = false;
    const float* scale; const bf16_t* GP; bf16_t* OAP; int g;
    __device__ __forceinline__ void operator()(const f32x4 (&acc)[2][2][4][2], const Unit& u, int wr, int wc, int fr, int fq) const {
        const int col0 = g * 256 + wc * 32 + 8 * fq;
        f32x4 sc[2][2];
#pragma unroll
        for (int bj = 0; bj < 2; ++bj) { sc[bj][0] = *(const f32x4*)(scale + col0 + bj * 128); sc[bj][1] = *(const f32x4*)(scale + col0 + bj * 128 + 4); }
        const int rowb = u.pm * 256 + wr * 64 + fr;
        u32x4 gb[2][2];
#define EP_LD(it, buf) do { const int row_ = rowb + ((it) >> 2) * 128 + ((it) & 3) * 16; const int rr_ = row_ < MROWS ? row_ : MROWS - 1; \
            _Pragma("unroll") for (int bj = 0; bj < 2; ++bj) gb[buf][bj] = *(const u32x4*)(GP + (size_t)rr_ * 1024 + col0 + bj * 128); } while (0)
        EP_LD(0, 0);
#pragma unroll
        for (int it = 0; it < 8; ++it) {
            if (it + 1 < 8) EP_LD(it + 1, (it + 1) & 1);
            const int ai = it >> 2, m = it & 3, row = rowb + ai * 128 + m * 16;
            if (row < MROWS) {
#pragma unroll
                for (int bj = 0; bj < 2; ++bj) {
                    const u32x4 gw = gb[it & 1][bj]; const f32x4 s0 = sc[bj][0], s1 = sc[bj][1];
                    const f32x4 a0 = acc[ai][bj][m][0], a1 = acc[ai][bj][m][1];
                    u32x4 w;
                    w.x = cvt_pk_bf16(a0[0] * s0[0] * bf_lo(gw.x), a0[1] * s0[1] * bf_hi(gw.x));
                    w.y = cvt_pk_bf16(a0[2] * s0[2] * bf_lo(gw.y), a0[3] * s0[3] * bf_hi(gw.y));
                    w.z = cvt_pk_bf16(a1[0] * s1[0] * bf_lo(gw.z), a1[1] * s1[1] * bf_hi(gw.z));
                    w.w = cvt_pk_bf16(a1[2] * s1[2] * bf_lo(gw.w), a1[3] * s1[3] * bf_hi(gw.w));
                    *(u32x4*)(OAP + (size_t)row * 2048 + 1024 + col0 + bj * 128) = w;
                }
            }
            asm volatile("" ::: "memory");
        }
#undef EP_LD
    }
};
struct EpiMerge {
    static constexpr bool PERM = true, MID = true;
    const bf16_t* SMA; const bf16_t* SMP; bf16_t* MG;
    static __device__ __forceinline__ float sfl(float v) { return fmaxf(v, 9.094947e-13f); }
    __device__ __forceinline__ void mid(f32x4 (&acc)[2][2][4][2], const Unit& u, int wr, int wc, int fr, int fq) const {
        asm volatile("" : "+v"(fr), "+v"(fq));
        const int col0 = u.pn * 256 + wc * 32 + 8 * fq;
        const int rowb = u.pm * 256 + wr * 64 + fr;
        u32x4 ga[2][2], gp[2][2];
#define EP_LD(it, buf) do { const size_t off_ = (size_t)(rowb + ((it) >> 2) * 128 + ((it) & 3) * 16) * 2048 + col0; \
            _Pragma("unroll") for (int bj = 0; bj < 2; ++bj) { ga[buf][bj] = *(const u32x4*)(SMA + off_ + bj * 128); gp[buf][bj] = *(const u32x4*)(SMP + off_ + bj * 128); } } while (0)
        EP_LD(0, 0);
#pragma unroll
        for (int it = 0; it < 8; ++it) {
            if (it + 1 < 8) EP_LD(it + 1, (it + 1) & 1);
            const int ai = it >> 2, m = it & 3;
#pragma unroll
            for (int bj = 0; bj < 2; ++bj) {
                const u32x4 a = ga[it & 1][bj], p = gp[it & 1][bj];
                f32x4 r0, r1;
                r0[0] = bf_lo(a.x) * __builtin_amdgcn_rcpf(sfl(bf_lo(p.x))); r0[1] = bf_hi(a.x) * __builtin_amdgcn_rcpf(sfl(bf_hi(p.x)));
                r0[2] = bf_lo(a.y) * __builtin_amdgcn_rcpf(sfl(bf_lo(p.y))); r0[3] = bf_hi(a.y) * __builtin_amdgcn_rcpf(sfl(bf_hi(p.y)));
                r1[0] = bf_lo(a.z) * __builtin_amdgcn_rcpf(sfl(bf_lo(p.z))); r1[1] = bf_hi(a.z) * __builtin_amdgcn_rcpf(sfl(bf_hi(p.z)));
                r1[2] = bf_lo(a.w) * __builtin_amdgcn_rcpf(sfl(bf_lo(p.w))); r1[3] = bf_hi(a.w) * __builtin_amdgcn_rcpf(sfl(bf_hi(p.w)));
                acc[ai][bj][m][0] = acc[ai][bj][m][0] * r0; acc[ai][bj][m][1] = acc[ai][bj][m][1] * r1;
            }
            asm volatile("" ::: "memory");
        }
#undef EP_LD
    }
    __device__ __forceinline__ void operator()(const f32x4 (&acc)[2][2][4][2], const Unit& u, int wr, int wc, int fr, int fq) const {
        const int col0 = u.pn * 256 + wc * 32 + 8 * fq;
        const int rowb = u.pm * 256 + wr * 64 + fr;
        u32x4 gp[2][2];
#define EP_LD(it, buf) do { const size_t off_ = (size_t)(rowb + ((it) >> 2) * 128 + ((it) & 3) * 16) * 2048 + col0; \
            _Pragma("unroll") for (int bj = 0; bj < 2; ++bj) gp[buf][bj] = *(const u32x4*)(SMP + off_ + bj * 128); } while (0)
        EP_LD(0, 0);
#pragma unroll
        for (int it = 0; it < 8; ++it) {
            if (it + 1 < 8) EP_LD(it + 1, (it + 1) & 1);
            const int ai = it >> 2, m = it & 3;
            const size_t off = (size_t)(rowb + ai * 128 + m * 16) * 2048 + col0;
#pragma unroll
            for (int bj = 0; bj < 2; ++bj) {
                const u32x4 p = gp[it & 1][bj];
                const f32x4 a0 = acc[ai][bj][m][0], a1 = acc[ai][bj][m][1];
                u32x4 w;
                w.x = cvt_pk_bf16(a0[0] * sfl(bf_lo(p.x)), a0[1] * sfl(bf_hi(p.x)));
                w.y = cvt_pk_bf16(a0[2] * sfl(bf_lo(p.y)), a0[3] * sfl(bf_hi(p.y)));
                w.z = cvt_pk_bf16(a1[0] * sfl(bf_lo(p.z)), a1[1] * sfl(bf_hi(p.z)));
                w.w = cvt_pk_bf16(a1[2] * sfl(bf_lo(p.w)), a1[3] * sfl(bf_hi(p.w)));
                *(u32x4*)(MG + off + bj * 128) = w;
            }
            asm volatile("" ::: "memory");
        }
#undef EP_LD
    }
};
struct EpiRes {
    static constexpr bool PERM = true, MID = false;
    const float* XIN; float* XS; bf16_t* HB; float* ssq;
    __device__ __forceinline__ void operator()(const f32x4 (&acc)[2][2][4][2], const Unit& u, int wr, int wc, int fr, int fq) const {
        const int col0 = u.pn * 256 + wc * 32 + 8 * fq;
        const int rowb = u.pm * 256 + wr * 64 + fr;
        const int lane = fq * 16 + fr;
        f32x4 xb[2][2][2];
#define EP_LD(it, buf) do { const size_t off_ = (size_t)(rowb + ((it) >> 2) * 128 + ((it) & 3) * 16) * 2048 + col0; \
            _Pragma("unroll") for (int bj = 0; bj < 2; ++bj) { xb[buf][bj][0] = *(const f32x4*)(XIN + off_ + bj * 128); xb[buf][bj][1] = *(const f32x4*)(XIN + off_ + bj * 128 + 4); } } while (0)
        EP_LD(0, 0);
#pragma unroll
        for (int it = 0; it < 8; ++it) {
            if (it + 1 < 8) EP_LD(it + 1, (it + 1) & 1);
            const int ai = it >> 2, m = it & 3, row = rowb + ai * 128 + m * 16;
            const size_t off = (size_t)row * 2048 + col0;
            float sq = 0.f;
#pragma unroll
            for (int bj = 0; bj < 2; ++bj) {
                const f32x4 n0 = xb[it & 1][bj][0] + acc[ai][bj][m][0], n1 = xb[it & 1][bj][1] + acc[ai][bj][m][1];
                *(f32x4*)(XS + off + bj * 128) = n0; *(f32x4*)(XS + off + bj * 128 + 4) = n1;
                u32x4 w; w.x = cvt_pk_bf16(n0[0], n0[1]); w.y = cvt_pk_bf16(n0[2], n0[3]); w.z = cvt_pk_bf16(n1[0], n1[1]); w.w = cvt_pk_bf16(n1[2], n1[3]);
                if (HB) *(u32x4*)(HB + off + bj * 128) = w;
                sq += (n0[0] * n0[0] + n0[1] * n0[1]) + (n0[2] * n0[2] + n0[3] * n0[3]) + (n1[0] * n1[0] + n1[1] * n1[1]) + (n1[2] * n1[2] + n1[3] * n1[3]);
            }
            sq += shfl_idx(sq, lane ^ 16); sq += shfl_idx(sq, lane ^ 32);
            if (fq == 0) atomicAdd(ssq + (size_t)row * SSQ_STRIDE, sq);
            asm volatile("" ::: "memory");
        }
#undef EP_LD
    }
};

struct EpiResFinal {
    static constexpr bool PERM = true, MID = false;
    const float* XIN; const float* gain; float* OUT; float* ssq; unsigned* pcnt;
    __device__ __forceinline__ void operator()(const f32x4 (&acc_c)[2][2][4][2], const Unit& u, int wr, int wc, int fr, int fq) const {
        f32x4 (&acc)[2][2][4][2] = const_cast<f32x4 (&)[2][2][4][2]>(acc_c);
        const int col0 = u.pn * 256 + wc * 32 + 8 * fq;
        const int rowb = u.pm * 256 + wr * 64 + fr;
        const int lane = fq * 16 + fr;
        f32x4 xb[2][2][2];
#define EP_LD(it, buf) do { const size_t off_ = (size_t)(rowb + ((it) >> 2) * 128 + ((it) & 3) * 16) * 2048 + col0; \
            _Pragma("unroll") for (int bj = 0; bj < 2; ++bj) { xb[buf][bj][0] = *(const f32x4*)(XIN + off_ + bj * 128); xb[buf][bj][1] = *(const f32x4*)(XIN + off_ + bj * 128 + 4); } } while (0)
        EP_LD(0, 0);
#pragma unroll
        for (int it = 0; it < 8; ++it) {
            if (it + 1 < 8) EP_LD(it + 1, (it + 1) & 1);
            const int ai = it >> 2, m = it & 3, row = rowb + ai * 128 + m * 16;
            float sq = 0.f;
#pragma unroll
            for (int bj = 0; bj < 2; ++bj) {
                const f32x4 n0 = xb[it & 1][bj][0] + acc[ai][bj][m][0], n1 = xb[it & 1][bj][1] + acc[ai][bj][m][1];
                acc[ai][bj][m][0] = n0; acc[ai][bj][m][1] = n1;
                sq += (n0[0] * n0[0] + n0[1] * n0[1]) + (n0[2] * n0[2] + n0[3] * n0[3]) + (n1[0] * n1[0] + n1[1] * n1[1]) + (n1[2] * n1[2] + n1[3] * n1[3]);
            }
            sq += shfl_idx(sq, lane ^ 16); sq += shfl_idx(sq, lane ^ 32);
            if (fq == 0) atomicAdd(ssq + (size_t)row * SSQ_STRIDE, sq);
            asm volatile("" ::: "memory");
        }
#undef EP_LD
        asm volatile("s_waitcnt vmcnt(0)" ::: "memory");
        __syncthreads();
        if (tid_fresh() == 0) {
            unsigned* pc = pcnt + u.pm * 16;
            __hip_atomic_fetch_add(pc, 1u, __ATOMIC_RELAXED, __HIP_MEMORY_SCOPE_AGENT);
            unsigned sp = 0;
            while (__hip_atomic_load(pc, __ATOMIC_RELAXED, __HIP_MEMORY_SCOPE_AGENT) < 8u && ++sp < (1u << 20)) __builtin_amdgcn_s_sleep(1);
        }
        __syncthreads();
        f32x4 gv[2][2];
#pragma unroll
        for (int bj = 0; bj < 2; ++bj) { gv[bj][0] = *(const f32x4*)(gain + col0 + bj * 128); gv[bj][1] = *(const f32x4*)(gain + col0 + bj * 128 + 4); }
        float ssv[8];
#pragma unroll
        for (int it = 0; it < 8; ++it) ssv[it] = __hip_atomic_load(ssq + (size_t)(rowb + (it >> 2) * 128 + (it & 3) * 16) * SSQ_STRIDE, __ATOMIC_RELAXED, __HIP_MEMORY_SCOPE_AGENT);
#pragma unroll
        for (int it = 0; it < 8; ++it) {
            const int ai = it >> 2, m = it & 3;
            const float r = __builtin_amdgcn_rsqf(ssv[it] * (1.0f / DM) + RMS_EPS);
            const size_t off = (size_t)(rowb + ai * 128 + m * 16) * 2048 + col0;
#pragma unroll
            for (int bj = 0; bj < 2; ++bj) {
                *(f32x4*)(OUT + off + bj * 128) = acc[ai][bj][m][0] * r * gv[bj][0]; *(f32x4*)(OUT + off + bj * 128 + 4) = acc[ai][bj][m][1] * r * gv[bj][1];
            }
        }
    }
};

struct Args {
    const float* x; const float* meta; const float* norm_gain; const float* w_in; const float* pool_w; const float* pool_scale;
    const float* w_attn_up; const float* w_pool_up; const float* w_out; const float* final_gain;
    float* out; unsigned char* ws; int ph_lo, ph_hi;
};

__device__ __forceinline__ void transpose_item(const float* W, int N, bf16_t* WT, int ldwt, int coff, LAS float* scr, int kb, int nb, int lane, const float* kgain = nullptr) {
    const int k0 = 64 * kb, n0 = 32 * nb;
    float tv[32];
#pragma unroll
    for (int i = 0; i < 32; ++i) { const int kk = 2 * i + (lane >> 5); tv[i] = W[(size_t)(k0 + kk) * N + n0 + (lane & 31)]; }
    if (kgain) {
#pragma unroll
        for (int i = 0; i < 32; ++i) tv[i] *= kgain[k0 + 2 * i + (lane >> 5)];
    }
#pragma unroll
    for (int i = 0; i < 32; ++i) { const int kk = 2 * i + (lane >> 5); scr[kk * 33 + (lane & 31)] = tv[i]; }
    asm volatile("s_waitcnt lgkmcnt(0)" ::: "memory");
    const int c = lane & 7;
#pragma unroll
    for (int j = 0; j < 4; ++j) { const int n = (lane >> 3) + 8 * j; const LAS float* s = scr + (8 * c) * 33 + n;
        u32x4 o; o.x = cvt_pk_bf16(s[0 * 33], s[1 * 33]); o.y = cvt_pk_bf16(s[2 * 33], s[3 * 33]); o.z = cvt_pk_bf16(s[4 * 33], s[5 * 33]); o.w = cvt_pk_bf16(s[6 * 33], s[7 * 33]);
        *(u32x4*)(WT + (size_t)(n0 + n) * ldwt + coff + k0 + 8 * c) = o; }
    asm volatile("s_waitcnt lgkmcnt(0)" ::: "memory");
}
__device__ __forceinline__ void rms_row_bf16(const float* xrow, const float* gain, bf16_t* orow, float* xs_out, int lane) {
    const f32x4* xr = (const f32x4*)xrow + lane;
    f32x4 v[8]; float s = 0.f;
#pragma unroll
    for (int j = 0; j < 8; ++j) { v[j] = xr[64 * j]; s += (v[j][0] * v[j][0] + v[j][1] * v[j][1]) + (v[j][2] * v[j][2] + v[j][3] * v[j][3]); }
    const float r = 1.0f / sqrtf(wave_sum(s, lane) * (1.0f / DM) + RMS_EPS);
    if (xs_out) {
#pragma unroll
        for (int j = 0; j < 8; ++j) ((f32x4*)xs_out + lane)[64 * j] = v[j];
    }
    const f32x4* gr = (const f32x4*)gain + lane;
    u32x2* o8 = (u32x2*)orow + lane;
#pragma unroll
    for (int j = 0; j < 8; ++j) { const f32x4 g = gr[64 * j]; u32x2 w; w.x = cvt_pk_bf16(v[j][0] * r * g[0], v[j][1] * r * g[1]); w.y = cvt_pk_bf16(v[j][2] * r * g[2], v[j][3] * r * g[3]); o8[64 * j] = w; }
}
__device__ __forceinline__ void init_row(const float* xrow, bf16_t* hrow, float* ssq, int lane) {
    const f32x4* xr = (const f32x4*)xrow + lane;
    f32x4 v[8]; float s = 0.f;
#pragma unroll
    for (int j = 0; j < 8; ++j) { v[j] = xr[64 * j]; s += (v[j][0] * v[j][0] + v[j][1] * v[j][1]) + (v[j][2] * v[j][2] + v[j][3] * v[j][3]); }
    s = wave_sum(s, lane);
    u32x2* o8 = (u32x2*)hrow + lane;
#pragma unroll
    for (int j = 0; j < 8; ++j) { u32x2 w; w.x = cvt_pk_bf16(v[j][0], v[j][1]); w.y = cvt_pk_bf16(v[j][2], v[j][3]); o8[64 * j] = w; }
    if (lane == 0) *ssq = s;
}
__device__ __forceinline__ void final_row(const float* xrow, const float* gain, float* orow, const float ssq, int lane) {
    const float r = 1.0f / sqrtf(ssq * (1.0f / DM) + RMS_EPS);
    const f32x4* xr = (const f32x4*)xrow + lane; const f32x4* gr = (const f32x4*)gain + lane;
#pragma unroll
    for (int j = 0; j < 8; ++j) ((f32x4*)orow + lane)[64 * j] = xr[64 * j] * r * gr[64 * j];
}
__device__ __forceinline__ void rms_row_f32(const float* xrow, const float* gain, float* orow, int lane) {
    const f32x4* xr = (const f32x4*)xrow + lane;
    f32x4 v[8]; float s = 0.f;
#pragma unroll
    for (int j = 0; j < 8; ++j) { v[j] = xr[64 * j]; s += (v[j][0] * v[j][0] + v[j][1] * v[j][1]) + (v[j][2] * v[j][2] + v[j][3] * v[j][3]); }
    const float r = 1.0f / sqrtf(wave_sum(s, lane) * (1.0f / DM) + RMS_EPS);
    const f32x4* gr = (const f32x4*)gain + lane;
#pragma unroll
    for (int j = 0; j < 8; ++j) { const f32x4 g = gr[64 * j]; ((f32x4*)orow + lane)[64 * j] = v[j] * r * g; }
}

constexpr int KS = 272;
constexpr int TILEB = 64 * KS;
constexpr int KTILEB = 64 * 256;
constexpr int ABUF = KTILEB + TILEB;
__device__ __forceinline__ float fexp2(float x) { return __builtin_amdgcn_exp2f(x); }
__device__ __forceinline__ float frcp(float x) { return __builtin_amdgcn_rcpf(x); }

__device__ __forceinline__ void attn_tile(LAS unsigned char* Kb, const int j, const int tq0, const int tq, const int l, const int lg, const int (&kofs)[4], const int vbase,
                                          const bf16x8 (&qf)[4], f32x4 (&o)[8], float& P) {
    LAS unsigned char* Vb = Kb + KTILEB;
    f32x4 s[4];
    float zf = 0.f; asm volatile("" : "+v"(zf));
#pragma unroll
    for (int g = 0; g < 4; ++g) s[g] = (f32x4){zf, zf, zf, zf};
#pragma unroll
    for (int dc = 0; dc < 4; ++dc)
#pragma unroll
        for (int g = 0; g < 4; ++g) { const bf16x8 kf = *(const LAS bf16x8*)(Kb + kofs[dc] + g * 1024); s[g] = __builtin_amdgcn_mfma_f32_16x16x32_bf16(kf, qf[dc], s[g], 0, 0, 0); }
    const bool need_mask = (64 * j + 63 >= tq0) || (j == 0);
    float beta[16], omb[16];
#pragma unroll
    for (int kk = 0; kk < 16; ++kk) {
        const float t = fexp2(-s[kk >> 2][kk & 3]), r = frcp(1.0f + t);
        beta[kk] = r; omb[kk] = 1.0f - r;
    }
    if (need_mask) {
        const int tk0 = 64 * j + 16 * lg;
#pragma unroll
        for (int kk = 0; kk < 16; ++kk) { const int tk = tk0 + kk; const bool valid = (tk >= TOFF) && (tk < tq); beta[kk] = valid ? beta[kk] : 0.0f; omb[kk] = valid ? omb[kk] : 1.0f; }
    }
    float e[16]; e[15] = 1.0f;
#pragma unroll
    for (int kk = 14; kk >= 0; --kk) e[kk] = e[kk + 1] * omb[kk + 1];
    const float T = e[0] * omb[0];
    const float T1 = shfl_idx(T, (l + 16) & 63), T2 = shfl_idx(T, (l + 32) & 63), T3 = shfl_idx(T, (l + 48) & 63);
    float G = 1.0f;
    if (lg <= 2) G *= T1;
    if (lg <= 1) G *= T2;
    if (lg == 0) G *= T3;
    const float c = P * G;
    P = P * ((T * T1) * (T2 * T3));
    float a[16];
#pragma unroll
    for (int kk = 0; kk < 16; ++kk) a[kk] = beta[kk] * (e[kk] * c);
    bf16x8 pa[2];
#pragma unroll
    for (int mm = 0; mm < 2; ++mm) {
        u32x4 wv; wv.x = cvt_pk_bf16(a[8 * mm + 0], a[8 * mm + 1]); wv.y = cvt_pk_bf16(a[8 * mm + 2], a[8 * mm + 3]); wv.z = cvt_pk_bf16(a[8 * mm + 4], a[8 * mm + 5]); wv.w = cvt_pk_bf16(a[8 * mm + 6], a[8 * mm + 7]);
        pa[mm] = __builtin_bit_cast(bf16x8, wv);
    }
#pragma unroll
    for (int dg = 0; dg < 8; ++dg)
#pragma unroll
        for (int mm = 0; mm < 2; ++mm) {
            const s16x4 v0 = __builtin_bit_cast(s16x4, __builtin_amdgcn_ds_read_tr16_b64_v4i16((LAS s16x4*)(Vb + vbase + (8 * mm) * KS + dg * 32)));
            const s16x4 v1 = __builtin_bit_cast(s16x4, __builtin_amdgcn_ds_read_tr16_b64_v4i16((LAS s16x4*)(Vb + vbase + (8 * mm + 4) * KS + dg * 32)));
            const bf16x8 vf = __builtin_shufflevector(v0, v1, 0, 1, 2, 3, 4, 5, 6, 7);
            o[dg] = __builtin_amdgcn_mfma_f32_16x16x32_bf16(vf, pa[mm], o[dg], 0, 0, 0);
        }
}

__device__ __forceinline__ void attn_unit(LAS unsigned char* lds, const bf16_t* __restrict__ QB, const bf16_t* __restrict__ KB, const bf16_t* __restrict__ VB,
                                          const bf16_t* __restrict__ GA, bf16_t* __restrict__ OAP, int b, int h, int qb) {
    const int tid = tid_fresh(), w = __builtin_amdgcn_readfirstlane(tid >> 6), l = tid & 63, qi = l & 15, lg = l >> 4;
    const int tq0 = 64 + 128 * qb + 16 * w;
    const bool wactive = (tq0 >= TOFF);
    const int tq = tq0 + qi;
    const int mrow = (tq0 >= 64) ? (b * 2048 + tq - 64) : (MREAL + (wactive ? tq - TOFF : 0));
    const int jtop = (qb >= 0) ? 2 * qb + 2 : 0, ntiles = jtop + 1;
    const int jw = wactive ? ((tq0 + 14) >> 6) : -1;
    bf16x8 qf[4];
#pragma unroll
    for (int dc = 0; dc < 4; ++dc) qf[dc] = *(const bf16x8*)(QB + (size_t)mrow * 1024 + h * 128 + dc * 32 + lg * 8);
    f32x4 o[8];
#pragma unroll
    for (int dg = 0; dg < 8; ++dg) o[dg] = (f32x4){0.f, 0.f, 0.f, 0.f};
    float P = 1.0f;
    const size_t gbase = ((size_t)b * LP) * 1024 + h * 128;
    u32x4 kr0[2], vr0[2], kr1[2], vr1[2];
#define ATT_GLOAD(KR, VR, j) do { _Pragma("unroll") for (int i_ = 0; i_ < 2; ++i_) { const int p_ = tid + 512 * i_, r_ = p_ >> 4, c_ = p_ & 15; const size_t off_ = gbase + (size_t)(64 * (j) + r_) * 1024 + c_ * 8; \
        KR[i_] = *(const u32x4*)(KB + off_); VR[i_] = *(const u32x4*)(VB + off_); } } while (0)
#define ATT_LWRITE(KR, VR, buf) do { _Pragma("unroll") for (int i_ = 0; i_ < 2; ++i_) { const int p_ = tid + 512 * i_, r_ = p_ >> 4, c_ = p_ & 15; \
        *(LAS u32x4*)(lds + (buf) * ABUF + r_ * 256 + ((c_ ^ ((r_ & 3) | (((r_ >> 4) & 3) << 2))) << 4)) = KR[i_]; *(LAS u32x4*)(lds + (buf) * ABUF + KTILEB + r_ * KS + c_ * 16) = VR[i_]; } } while (0)
    LAS volatile int* flags = (LAS volatile int*)(lds + MISC_OFF + 64);
    ATT_GLOAD(kr0, vr0, jtop);
    u32x2 gwv[8];
#pragma unroll
    for (int dg = 0; dg < 8; ++dg) gwv[dg] = *(const u32x2*)(GA + (size_t)mrow * 1024 + h * 128 + 16 * dg + 4 * lg);
    if (ntiles > 1) ATT_GLOAD(kr1, vr1, jtop - 1);
    ATT_LWRITE(kr0, vr0, 0);
    __syncthreads();
    int kofs[4];
#pragma unroll
    for (int dc = 0; dc < 4; ++dc) kofs[dc] = (16 * (qi >> 2) + (qi & 3)) * 256 + (((4 * dc + lg) ^ qi) << 4);
    const int vbase = (16 * lg + (qi >> 2)) * KS + (qi & 3) * 8;
#define ATT_ITER(it, KRF, VRF, KRN, VRN) { \
        const int j = jtop - (it), cur = (it) & 1; \
        if ((it) + 2 < ntiles) ATT_GLOAD(KRF, VRF, j - 2); \
        if (j <= jw) attn_tile(lds + cur * ABUF, j, tq0, tq, l, lg, kofs, vbase, qf, o, P); \
        if ((it) + 1 < ntiles) ATT_LWRITE(KRN, VRN, cur ^ 1); \
        { const bool wdone = !wactive || (j <= jw && __builtin_amdgcn_ballot_w64(P != 0.0f) == 0ull); \
          if (l == 0) flags[cur * 8 + w] = wdone ? 1 : 0; } \
        __syncthreads(); \
        { int alld = 1; _Pragma("unroll") for (int ww = 0; ww < 8; ++ww) alld &= flags[cur * 8 + ww]; if (alld) break; } }
    for (int it = 0; it < ntiles; it += 2) {
        ATT_ITER(it, kr0, vr0, kr1, vr1)
        if (it + 1 >= ntiles) break;
        ATT_ITER(it + 1, kr1, vr1, kr0, vr0)
    }
#undef ATT_ITER
#undef ATT_GLOAD
#undef ATT_LWRITE
    if (wactive) {
#pragma unroll
        for (int dg = 0; dg < 8; ++dg) {
            const size_t col = (size_t)h * 128 + 16 * dg + 4 * lg;
            const u32x2 gw = gwv[dg];
            u32x2 wv; wv.x = cvt_pk_bf16(o[dg][0] * bf_lo(gw.x), o[dg][1] * bf_hi(gw.x)); wv.y = cvt_pk_bf16(o[dg][2] * bf_lo(gw.y), o[dg][3] * bf_hi(gw.y));
            *(u32x2*)(OAP + (size_t)mrow * 2048 + col) = wv;
        }
    }
}

__device__ __forceinline__ void load8f(const bf16_t* p, float (&f)[8]) {
    const u32x4 w = *(const u32x4*)p;
    f[0] = bf_lo(w.x); f[1] = bf_hi(w.x); f[2] = bf_lo(w.y); f[3] = bf_hi(w.y); f[4] = bf_lo(w.z); f[5] = bf_hi(w.z); f[6] = bf_lo(w.w); f[7] = bf_hi(w.w);
}
template <int W>
__device__ __forceinline__ void pool_prepass(const bf16_t* __restrict__ up, bf16_t* __restrict__ op, const int t0) {
    u32x4 raw[W - 1 + 16];
#pragma unroll
    for (int r = 0; r < W - 1 + 16; ++r) raw[r] = *(const u32x4*)(up + (ptrdiff_t)(r - (W - 1)) * 1024);
    float S[8];
#pragma unroll
    for (int e = 0; e < 8; ++e) S[e] = 0.f;
#pragma unroll
    for (int r = 0; r < W - 1; ++r) { const u32x4 q = raw[r]; S[0] += bf_lo(q.x); S[1] += bf_hi(q.x); S[2] += bf_lo(q.y); S[3] += bf_hi(q.y); S[4] += bf_lo(q.z); S[5] += bf_hi(q.z); S[6] += bf_lo(q.w); S[7] += bf_hi(q.w); }
#pragma unroll
    for (int rr = 0; rr < 16; ++rr) {
        const u32x4 q = raw[W - 1 + rr];
        float cu[8] = {bf_lo(q.x), bf_hi(q.x), bf_lo(q.y), bf_hi(q.y), bf_lo(q.z), bf_hi(q.z), bf_lo(q.w), bf_hi(q.w)};
        if (rr > 0) { const u32x4 p = raw[rr - 1]; S[0] -= bf_lo(p.x); S[1] -= bf_hi(p.x); S[2] -= bf_lo(p.y); S[3] -= bf_hi(p.y); S[4] -= bf_lo(p.z); S[5] -= bf_hi(p.z); S[6] -= bf_lo(p.w); S[7] -= bf_hi(p.w); }
#pragma unroll
        for (int e = 0; e < 8; ++e) S[e] += cu[e];
        const int t = t0 + rr; const float inv = 1.0f / (float)((t + 1) < W ? (t + 1) : W);
        u32x4 o; o.x = cvt_pk_bf16(S[0] * inv - cu[0], S[1] * inv - cu[1]); o.y = cvt_pk_bf16(S[2] * inv - cu[2], S[3] * inv - cu[3]);
        o.z = cvt_pk_bf16(S[4] * inv - cu[4], S[5] * inv - cu[5]); o.w = cvt_pk_bf16(S[6] * inv - cu[6], S[7] * inv - cu[7]);
        *(u32x4*)(op + (size_t)rr * 1024) = o;
    }
}
__device__ __forceinline__ void pool_unit(LAS unsigned char* lds, const bf16_t* __restrict__ UB, bf16_t* __restrict__ PL, const bf16_t* PWT  , const float* scale  ,
                                          const bf16_t* GP, bf16_t* OAP, int pm, int g) {
    const int tid = tid_fresh(), cc = tid & 31, strip = tid >> 5;
    int b, tb, m0; bool valid = true;
    if (pm < 32) { const int r0 = pm * 256 + strip * 16; b = r0 >> 11; tb = 64 + (r0 & 2047); m0 = r0; }
    else { b = 0; tb = TOFF; m0 = MREAL; valid = strip == 0; }
    if (valid) {
        const bf16_t* up = UB + ((size_t)(b * LP + tb)) * 1024 + g * 256 + cc * 8;
        bf16_t* op = PL + (size_t)m0 * 1024 + g * 256 + cc * 8;
        if (g == 0) pool_prepass<2>(up, op, tb - TOFF);
        else if (g == 1) pool_prepass<4>(up, op, tb - TOFF);
        else if (g == 2) pool_prepass<8>(up, op, tb - TOFF);
        else pool_prepass<16>(up, op, tb - TOFF);
    }
    asm volatile("s_waitcnt vmcnt(0)" ::: "memory");
    __syncthreads();
    pg8::Gemm gm{PL + g * 256, PWT + (size_t)g * GD * GD};
    pg8::OneUnit S1{{pm, 0}};
    EpiPool E{scale, GP, OAP, g};
    pg8::gemm_phase<EpiPool, pg8::OneUnit, 1024, 256, 256>(lds, gm, S1, E);
}

__device__ __forceinline__ f32x4 skinny_part(const bf16_t* __restrict__ wp, const bf16_t* __restrict__ hp) {
    bf16x8 wv[8], hv[8];
#pragma unroll
    for (int u = 0; u < 8; ++u) { wv[u] = *(const bf16x8*)(wp + 32 * u); hv[u] = *(const bf16x8*)(hp + 32 * u); }
    f32x4 acc = (f32x4){0.f, 0.f, 0.f, 0.f};
#pragma unroll
    for (int u = 0; u < 8; ++u) acc = __builtin_amdgcn_mfma_f32_16x16x32_bf16(wv[u], hv[u], acc, 0, 0, 0);
    return acc;
}
__device__ __forceinline__ void skinny_reduce(LAS unsigned char* lds, const f32x4 part, const int wave, const int lane, f32x4& lo4, f32x4& hi4) {
    LAS f32x4* red = (LAS f32x4*)lds;
    __syncthreads();
    red[wave * 64 + lane] = part;
    __syncthreads();
    if (wave == 0) {
        lo4 = (red[lane] + red[64 + lane]) + (red[128 + lane] + red[192 + lane]);
        hi4 = (red[256 + lane] + red[320 + lane]) + (red[384 + lane] + red[448 + lane]);
    }
}
__device__ __forceinline__ void skinny_in(LAS unsigned char* lds, unsigned char* ws, const bf16_t* WINL, const float* ssq, const int bx, const int G, const int wave, const int lane, const bool kvu_only) {
    const bf16_t* HB = (const bf16_t*)(ws + WS_HB);
    const int t = lane & 15, g4 = lane >> 4;
    for (int tk = bx; tk < (kvu_only ? 192 : INC / 16); tk += G) {
        const int nt = kvu_only ? (tk < 128 ? 64 + tk : 256 + (tk - 128)) : tk;
        const int n0 = nt * 16;
        const f32x4 part = skinny_part(WINL + (size_t)(n0 + t) * DM + wave * 256 + g4 * 8, HB + (size_t)(MREAL + t) * DM + wave * 256 + g4 * 8);
        f32x4 lo4, hi4; skinny_reduce(lds, part, wave, lane, lo4, hi4);
        if (wave == 0) {
            f32x4 v = (lo4 + hi4) * __builtin_amdgcn_rsqf(ssq[(size_t)(MREAL + t) * SSQ_STRIDE] * (1.0f / DM) + RMS_EPS);
            const int c = n0 + 4 * g4;
            int mode, ld = 1024, cb; size_t boff; bool bt = false;
            if (c < 1024)      { mode = 0; boff = WS_QB; cb = c; }
            else if (c < 2048) { mode = 1; boff = WS_KB; cb = c - 1024; bt = true; }
            else if (c < 3072) { mode = 1; boff = WS_VB; cb = c - 2048; bt = true; }
            else if (c < 4096) { mode = 2; boff = WS_GA; cb = c - 3072; }
            else if (c < 5120) { mode = 1; boff = WS_UB; cb = c - 4096; bt = true; }
            else if (c < 6144) { mode = 2; boff = WS_GP; cb = c - 5120; }
            else if (c < 8192) { mode = 3; boff = WS_SMA; cb = c - 6144; ld = 2048; }
            else               { mode = 3; boff = WS_SMP; cb = c - 8192; ld = 2048; }
            if (mode == 0) v = v * QSCALE;
            else if (mode == 2) { for (int e = 0; e < 4; ++e) v[e] = v[e] * fsigmoid(v[e]); }
            else if (mode == 3) { for (int e = 0; e < 4; ++e) v[e] = fsigmoid(v[e]); }
            u32x2 w; w.x = cvt_pk_bf16(v[0], v[1]); w.y = cvt_pk_bf16(v[2], v[3]);
            bf16_t* base = (bf16_t*)(ws + boff);
            if (bt) {
#pragma unroll
                for (int b = 0; b < NB; ++b) *(u32x2*)(base + (size_t)(b * LP + TOFF + t) * 1024 + cb) = w;
            } else *(u32x2*)(base + (size_t)(MREAL + t) * ld + cb) = w;
        }
    }
}
__device__ __forceinline__ void skinny_merge(LAS unsigned char* lds, unsigned char* ws, const bf16_t* WML, const int bx, const int G, const int wave, const int lane) {
    const bf16_t* OAP = (const bf16_t*)(ws + WS_OAP); const bf16_t* SMA = (const bf16_t*)(ws + WS_SMA); const bf16_t* SMP = (const bf16_t*)(ws + WS_SMP); bf16_t* MG = (bf16_t*)(ws + WS_MG);
    const int t = lane & 15, g4 = lane >> 4;
    for (int nt = bx; nt < DM / 16; nt += G) {
        const int n0 = nt * 16;
        const f32x4 part = skinny_part(WML + (size_t)(n0 + t) * DM + wave * 256 + g4 * 8, OAP + (size_t)(MREAL + t) * DM + wave * 256 + g4 * 8);
        f32x4 y1, y2; skinny_reduce(lds, part, wave, lane, y1, y2);
        if (wave == 0) {
            const size_t off = (size_t)(MREAL + t) * DM + n0 + 4 * g4;
            const u32x2 ga = *(const u32x2*)(SMA + off), gp = *(const u32x2*)(SMP + off);
            u32x2 w;
            w.x = cvt_pk_bf16(y1[0] * bf_lo(ga.x) + y2[0] * bf_lo(gp.x), y1[1] * bf_hi(ga.x) + y2[1] * bf_hi(gp.x));
            w.y = cvt_pk_bf16(y1[2] * bf_lo(ga.y) + y2[2] * bf_lo(gp.y), y1[3] * bf_hi(ga.y) + y2[3] * bf_hi(gp.y));
            *(u32x2*)(MG + off) = w;
        }
    }
}
__device__ __forceinline__ void skinny_out(LAS unsigned char* lds, unsigned char* ws, const bf16_t* WOL, const float* xin  , float* ssq, const int bx, const int G, const int wave, const int lane) {
    const bf16_t* MG = (const bf16_t*)(ws + WS_MG); float* XS = (float*)(ws + WS_XS); bf16_t* HB = (bf16_t*)(ws + WS_HB);
    const int t = lane & 15, g4 = lane >> 4;
    for (int nt = bx; nt < DM / 16; nt += G) {
        const int n0 = nt * 16;
        const f32x4 part = skinny_part(WOL + (size_t)(n0 + t) * DM + wave * 256 + g4 * 8, MG + (size_t)(MREAL + t) * DM + wave * 256 + g4 * 8);
        f32x4 lo4, hi4; skinny_reduce(lds, part, wave, lane, lo4, hi4);
        if (wave == 0) {
            f32x4* xp = (f32x4*)(XS + (size_t)(MREAL + t) * DM + n0 + 4 * g4);
            const f32x4 nv = *(const f32x4*)(xin + (size_t)t * DM + n0 + 4 * g4) + (lo4 + hi4);
            *xp = nv;
            u32x2 w; w.x = cvt_pk_bf16(nv[0], nv[1]); w.y = cvt_pk_bf16(nv[2], nv[3]);
            *(u32x2*)(HB + (size_t)(MREAL + t) * DM + n0 + 4 * g4) = w;
            float sq = (nv[0] * nv[0] + nv[1] * nv[1]) + (nv[2] * nv[2] + nv[3] * nv[3]);
            sq += shfl_idx(sq, lane ^ 16); sq += shfl_idx(sq, lane ^ 32);
            if (g4 == 0) atomicAdd(ssq + (size_t)(MREAL + t) * SSQ_STRIDE, sq);
        }
    }
}

constexpr int PH_PRO = 0, PH_FINAL = 1 + 5 * DEPTH, N_PHASES = PH_FINAL + 1;
constexpr int N_ATT = 32 * 16, N_POOLU = 33 * 4, N_METAU = 8, N_BITEMS = N_ATT + N_POOLU + N_METAU;

#define RLX_AGENT __ATOMIC_RELAXED, __HIP_MEMORY_SCOPE_AGENT
#define XB_TMO      128
#define XB_XCNT(j)  (256  + 64 * (j))
#define XB_XSUB(j)  (1280 + 64 * (j))
#define XB_XGEN(j)  (2304 + 64 * (j))
#define XB_TOP      3328
#define XB_TOPGEN   3392
#define XCD_BAR_WORDS 3456
#define XB_SPIN_CAP (1u << 18)

__device__ __forceinline__ unsigned xb_ld(unsigned* p)              { return __hip_atomic_load(p, __ATOMIC_RELAXED, __HIP_MEMORY_SCOPE_AGENT); }
__device__ __forceinline__ unsigned xb_add(unsigned* p, unsigned v) { return __hip_atomic_fetch_add(p, v, __ATOMIC_RELAXED, __HIP_MEMORY_SCOPE_AGENT); }
__device__ __forceinline__ unsigned xb_xcc_id() { return (unsigned)__builtin_amdgcn_s_getreg((3 << 11) | 20) & 0xFu; }
#define XB_SPIN(cond, bar) do { unsigned _sp = 0; while (cond) { __builtin_amdgcn_s_sleep(1); \
    if ((++_sp & 255u) == 0u) { if (xb_ld(&(bar)[XB_TMO])) break; if (_sp > XB_SPIN_CAP) { atomicAdd(&(bar)[XB_TMO], 1u); break; } } } } while (0)

struct XcdBarrier {
    unsigned* bar; unsigned x;
    volatile LAS unsigned* st;
};

__device__ __forceinline__ XcdBarrier xcd_barrier_post(unsigned* bar, volatile LAS unsigned* st) {
    XcdBarrier b; b.bar = bar; b.x = xb_xcc_id(); b.st = st;
    if (threadIdx.x == 0) (void)xb_add(&bar[XB_XCNT(b.x)], 1u);
    return b;
}
__device__ __forceinline__ void xcd_barrier_complete(unsigned* bar, unsigned x, unsigned& nloc, unsigned& nx) {
    const unsigned G = gridDim.x * gridDim.y * gridDim.z;
    unsigned sum, cnt, mine, sp = 0u;
    for (;;) {
        sum = 0u; cnt = 0u; mine = 0u;
#pragma unroll
        for (unsigned j = 0; j < 16; ++j) { const unsigned c = xb_ld(&bar[XB_XCNT(j)]); sum += c; cnt += (c > 0u) ? 1u : 0u; mine = (j == x) ? c : mine; }
        if (sum == G) break;
        __builtin_amdgcn_s_sleep(1);
        if ((++sp & 255u) == 0u) { if (xb_ld(&bar[XB_TMO])) break; if (sp > XB_SPIN_CAP) { atomicAdd(&bar[XB_TMO], 1u); break; } }
    }
    nloc = mine > 0u ? mine : 1u; nx = cnt > 0u ? cnt : 1u;
}

__device__ __forceinline__ void xcd_barrier(const XcdBarrier& b) {
    asm volatile("s_waitcnt vmcnt(0)" ::: "memory");
    __syncthreads();
    if (threadIdx.x == 0) {
        unsigned* bar = b.bar;
        __builtin_amdgcn_s_waitcnt(0);
        unsigned nloc = b.st[0], nx = b.st[1];
        if (nloc == 0u) { xcd_barrier_complete(bar, b.x, nloc, nx); b.st[0] = nloc; b.st[1] = nx; }
        const unsigned old = xb_add(&bar[XB_XSUB(b.x)], 1u);
        const unsigned gen = old / nloc;
        if (old + 1u == (gen + 1u) * nloc) {
            __builtin_amdgcn_fence(__ATOMIC_RELEASE, "agent");
            asm volatile("s_waitcnt vmcnt(0)" ::: "memory");
            const unsigned og = xb_add(&bar[XB_TOP], 1u);
            const unsigned tg = og / nx;
            if (og + 1u == (tg + 1u) * nx) xb_add(&bar[XB_TOPGEN], 1u);
            else XB_SPIN(xb_ld(&bar[XB_TOPGEN]) == tg, bar);
            __builtin_amdgcn_fence(__ATOMIC_ACQUIRE, "agent");
            xb_add(&bar[XB_XGEN(b.x)], 1u);
            asm volatile("s_waitcnt vmcnt(0)" ::: "memory");
        } else {
            XB_SPIN(xb_ld(&bar[XB_XGEN(b.x)]) == gen, bar);
            __builtin_amdgcn_fence(__ATOMIC_ACQUIRE, "agent");
            asm volatile("s_waitcnt vmcnt(0)" ::: "memory");
        }
    }
    __syncthreads();
}


__device__ __forceinline__ void grid_bar(unsigned* cnt, unsigned target) {
    asm volatile("s_waitcnt vmcnt(0)" ::: "memory");
    __syncthreads();
    if (tid_fresh() == 0) {
        __builtin_amdgcn_fence(__ATOMIC_RELEASE, "agent");
        asm volatile("s_waitcnt vmcnt(0)" ::: "memory");
        __hip_atomic_fetch_add(cnt, 1u, __ATOMIC_RELAXED, __HIP_MEMORY_SCOPE_AGENT);
        while (__hip_atomic_load(cnt, __ATOMIC_RELAXED, __HIP_MEMORY_SCOPE_AGENT) < target) __builtin_amdgcn_s_sleep(1);
        __builtin_amdgcn_fence(__ATOMIC_ACQUIRE, "agent");
        asm volatile("s_waitcnt vmcnt(0)" ::: "memory");
    }
    __syncthreads();
}

#define TID_VARS() const int tid = tid_fresh(), lane = tid & 63, wave = __builtin_amdgcn_readfirstlane(tid >> 6); const int gw = bx * 8 + wave, NGW = G * 8; (void)lane; (void)gw; (void)NGW; (void)tid;
#define WS_PTRS() \
    unsigned char* ws = args.ws; asm volatile("" : "+s"(ws)); \
    unsigned* ctl = (unsigned*)(ws + WS_CTL); (void)ctl; \
    float* XS = (float*)(ws + WS_XS); bf16_t* HB = (bf16_t*)(ws + WS_HB); (void)XS; (void)HB; \
    bf16_t* WIN = (bf16_t*)(ws + WS_WIN); bf16_t* WM = (bf16_t*)(ws + WS_WM); bf16_t* WO = (bf16_t*)(ws + WS_WO); bf16_t* PWT = (bf16_t*)(ws + WS_PW); (void)WIN; (void)WM; (void)WO; (void)PWT; \
    bf16_t* QB = (bf16_t*)(ws + WS_QB); bf16_t* KB = (bf16_t*)(ws + WS_KB); bf16_t* VB = (bf16_t*)(ws + WS_VB); bf16_t* UB = (bf16_t*)(ws + WS_UB); (void)QB; (void)KB; (void)VB; (void)UB; \
    bf16_t* GA = (bf16_t*)(ws + WS_GA); bf16_t* GP = (bf16_t*)(ws + WS_GP); bf16_t* SMA = (bf16_t*)(ws + WS_SMA); bf16_t* SMP = (bf16_t*)(ws + WS_SMP); (void)GA; (void)GP; (void)SMA; (void)SMP; \
    bf16_t* OAP = (bf16_t*)(ws + WS_OAP); bf16_t* PL = (bf16_t*)(ws + WS_PL); float* T1 = (float*)(ws + WS_T1); bf16_t* MG = (bf16_t*)(ws + WS_MG); (void)OAP; (void)PL; (void)T1; (void)MG;
#define IN(k) (lo <= (k) && (k) < hi)
#if MK_MULTI
#define SEAM(k) do { } while (0)
#else
#ifdef PROBE_SEL
#define STAMP(k) do { if (bx == 0 && tid_fresh() == 0) ((unsigned long long*)(args.ws + WS_CTL + 2048))[(k)] = __builtin_amdgcn_s_memrealtime(); } while (0)
#else
#define STAMP(k) do { } while (0)
#endif
#define SEAM(k) do { if (IN(k) && IN((k) + 1)) { unsigned char* wsb = args.ws; asm volatile("" : "+s"(wsb)); ++nbar; xcd_barrier(xbar); STAMP((k) + 1); } } while (0)
#endif

template <int L, int COFF>
__device__ __forceinline__ void layer_phases(const Args& args, LAS unsigned char* lds, const int G, const int bx, const int lo, const int hi, unsigned& nbar, const XcdBarrier& xbar) {
    constexpr int P0 = 1 + 5 * L;
    if (IN(P0 + 1)) {
        WS_PTRS();
#ifndef DIS_A
        for (int rep = 0; rep < REP_A; ++rep) {
        pg8::Gemm g{HB, WIN + (size_t)L * INC * DM}; pg8::StaticOrder S; S.init(MREAL, INC, G, bx);
        EpiIn E{ws, (const float*)(ws + WS_SSQ) + (size_t)L * MPAD * SSQ_STRIDE};
        pg8::gemm_phase<EpiIn, pg8::StaticOrder, DM, DM, DM>(lds, g, S, E);
        }
#endif
        { TID_VARS(); skinny_in(lds, ws, WIN + (size_t)L * INC * DM, (const float*)(ws + WS_SSQ) + (size_t)L * MPAD * SSQ_STRIDE, bx, G, wave, lane, L + 1 == DEPTH); }
    }
    SEAM(P0 + 1);
    if (IN(P0 + 2)) {
        WS_PTRS();
        LAS volatile int* item_s = (LAS volatile int*)(lds + MISC_OFF);
        for (int rep = 0; rep < REP_B; ++rep) {
            unsigned* ctr = ctl + L + 8 * rep + COFF;
            __syncthreads();
            if (tid_fresh() == 0) item_s[0] = (int)atomicAdd(ctr, 1u);
            __syncthreads();
            int item = __builtin_amdgcn_readfirstlane(item_s[0]);
            int par = 1;
            while (item < N_BITEMS) {
                int nxt = 0; if (tid_fresh() == 0) nxt = (int)atomicAdd(ctr, 1u);
#ifndef DIS_B
                if (L + 1 == DEPTH && (item >= N_POOLU + N_ATT || (item >> 2) == 32)) {
                } else if (item >= N_POOLU) {
                    const int ia = item - N_POOLU;
                    const int qb = ia < N_ATT ? 15 - ia / 32 : -1, bh = ia < N_ATT ? ia % 32 : ia - N_ATT;
                    attn_unit(lds, QB, KB, VB, GA, OAP, bh >> 3, bh & 7, qb);
                } else {
                    pool_unit(lds, UB, PL, PWT + (size_t)L * 4 * GD * GD, args.pool_scale + (size_t)L * PWD, GP, OAP, item >> 2, item & 3);
                }
#endif
                if (tid_fresh() == 0) item_s[par] = nxt;
                __syncthreads();
                item = __builtin_amdgcn_readfirstlane(item_s[par]);
                par ^= 1;
            }
        }
    }
    SEAM(P0 + 2);
    if (IN(P0 + 3)) {
        WS_PTRS();
        pg8::StaticOrder S; S.init(MREAL, DM, G, bx);
#ifndef DIS_C
        for (int rep = 0; rep < REP_C; ++rep) {
        { pg8::Gemm g{OAP, WM + (size_t)L * DM * DM}; EpiMerge E{SMA, SMP, MG}; pg8::gemm_phase<EpiMerge, pg8::StaticOrder, DM, DM, DM>(lds, g, S, E); }
        }
#endif
        if (L + 1 < DEPTH) { TID_VARS(); skinny_merge(lds, ws, WM + (size_t)L * DM * DM, bx, G, wave, lane); }
    }
    SEAM(P0 + 3);
    if (IN(P0 + 4)) {
        WS_PTRS();
#ifndef DIS_D
        pg8::Gemm g{MG, WO + (size_t)L * DM * DM}; pg8::StaticOrder S; S.init(MREAL, DM, G, bx);
        if (L == DEPTH - 1 && G >= (MREAL / 256) * (DM / 256)) {
            EpiResFinal E{(const float*)XS, args.final_gain, args.out, (float*)(ws + WS_SSQ) + (size_t)(L + 1) * MPAD * SSQ_STRIDE, (unsigned*)(ws + WS_BAR) + XCD_BAR_WORDS};
            pg8::gemm_phase<EpiResFinal, pg8::StaticOrder, DM, DM, DM>(lds, g, S, E);
        } else {
        EpiRes E{L == 0 ? args.x : (const float*)XS, XS, L == DEPTH - 1 ? (bf16_t*)nullptr : HB, (float*)(ws + WS_SSQ) + (size_t)(L + 1) * MPAD * SSQ_STRIDE};
        pg8::gemm_phase<EpiRes, pg8::StaticOrder, DM, DM, DM>(lds, g, S, E);
        }
#endif
        if (L + 1 < DEPTH) { TID_VARS(); skinny_out(lds, ws, WO + (size_t)L * DM * DM, L == 0 ? args.meta : (const float*)(XS + (size_t)MREAL * DM), (float*)(ws + WS_SSQ) + (size_t)(L + 1) * MPAD * SSQ_STRIDE, bx, G, wave, lane); }
    }
    if (!(L == DEPTH - 1 && G >= (MREAL / 256) * (DM / 256))) SEAM(P0 + 4);
}

template <int COFF>
__device__ __forceinline__ void run_all(const Args& args, LAS unsigned char* lds, const int G, const int bx, const int lo, const int hi, unsigned& nbar, const XcdBarrier& xbar) {
    if (IN(PH_PRO)) {
        WS_PTRS(); TID_VARS();
#ifndef DIS_PRO
        for (int rep = 0; rep < REP_PRO; ++rep) {
        LAS float* scr = (LAS float*)(lds + wave * 8704);
        constexpr int I_IN = 32 * 320, I_UP = 16 * 64, I_OUT = 32 * 64, I_PW = 4 * 8;
        constexpr int PER_L = I_IN + 2 * I_UP + I_OUT + 4 * I_PW;
        for (int it = gw; it < DEPTH * PER_L; it += NGW) {
            const int L = it / PER_L; int r = it % PER_L;
            if (r < I_IN) { transpose_item(args.w_in + (size_t)L * DM * INC, INC, WIN + (size_t)L * INC * DM, DM, 0, scr, r / 320, r % 320, lane, args.norm_gain + (size_t)L * DM); continue; } r -= I_IN;
            if (r < I_UP) { transpose_item(args.w_attn_up + (size_t)L * SBW * DM, DM, WM + (size_t)L * DM * DM, DM, 0, scr, r / 64, r % 64, lane); continue; } r -= I_UP;
            if (r < I_UP) { transpose_item(args.w_pool_up + (size_t)L * PWD * DM, DM, WM + (size_t)L * DM * DM, DM, 1024, scr, r / 64, r % 64, lane); continue; } r -= I_UP;
            if (r < I_OUT) { transpose_item(args.w_out + (size_t)L * DM * DM, DM, WO + (size_t)L * DM * DM, DM, 0, scr, r / 64, r % 64, lane); continue; } r -= I_OUT;
            { const int gq = r / I_PW, rr = r % I_PW; transpose_item(args.pool_w + ((size_t)L * 4 + gq) * GD * GD, GD, PWT + ((size_t)L * 4 + gq) * GD * GD, GD, 0, scr, rr / 8, rr % 8, lane); }
        }
        }
#endif
        for (int m = gw; m < MROWS; m += NGW) {
            const float* src = (m < MREAL) ? args.x + (size_t)m * DM : args.meta + (size_t)(m - MREAL) * DM;
            init_row(src, HB + (size_t)m * DM, (float*)(ws + WS_SSQ) + (size_t)m * SSQ_STRIDE, lane);
        }
        { unsigned zu = 0u; asm volatile("" : "+v"(zu)); const int gt = bx * 512 + tid, NGT = G * 512; constexpr int PIECES = NB * TOFF * 128;
          for (int p = gt; p < 3 * PIECES; p += NGT) { const int bufi = p / PIECES, q = p % PIECES, bb = q / (TOFF * 128), rem = q % (TOFF * 128);
              bf16_t* base = bufi == 0 ? KB : (bufi == 1 ? VB : UB);
              *(u32x4*)(base + (size_t)bb * LP * 1024 + (size_t)rem * 8) = (u32x4){zu, zu, zu, zu}; } }
    }
    SEAM(PH_PRO);
    layer_phases<0, COFF>(args, lds, G, bx, lo, hi, nbar, xbar);
    layer_phases<1, COFF>(args, lds, G, bx, lo, hi, nbar, xbar);
    layer_phases<2, COFF>(args, lds, G, bx, lo, hi, nbar, xbar);
    layer_phases<3, COFF>(args, lds, G, bx, lo, hi, nbar, xbar);
    if (IN(PH_FINAL) && G < (MREAL / 256) * (DM / 256)) {
        WS_PTRS(); TID_VARS();
        for (int m = gw; m < MREAL; m += NGW) final_row(XS + (size_t)m * DM, args.final_gain, args.out + (size_t)m * DM, ((const float*)(ws + WS_SSQ))[((size_t)DEPTH * MPAD + m) * SSQ_STRIDE], lane);
    }
}

__global__ void __launch_bounds__(512, 2) mega_fwd(Args args) {
    extern __shared__ __attribute__((aligned(16))) unsigned char lds_raw[];
    LAS unsigned char* lds = (LAS unsigned char*)lds_raw;
    cg::grid_group grid = cg::this_grid();
    const int G = gridDim.x, bx = blockIdx.x;
    const int lo = args.ph_lo, hi = args.ph_hi;
    if (hi < 0) grid.sync();
    unsigned nbar = 0;
    { LAS unsigned* mw = (LAS unsigned*)(lds + MISC_OFF + 256); if (tid_fresh() < 4) mw[tid_fresh()] = 0u; __syncthreads(); }
    const XcdBarrier xbar = xcd_barrier_post((unsigned*)(args.ws + WS_BAR), (volatile LAS unsigned*)(lds + MISC_OFF + 256));
    STAMP(0);
    run_all<0>(args, lds, G, bx, lo, hi, nbar, xbar);
#ifdef PROBE_SEL
    if (bx == 0) { __syncthreads(); if (tid_fresh() == 0) {
        const unsigned long long* st = (const unsigned long long*)(args.ws + WS_CTL + 2048);
        const unsigned long long tend = __builtin_amdgcn_s_memrealtime();
        float v = 0.f;
        if (PROBE_SEL == 0) v = (float)(st[1] - st[0]) * 0.01f;
        else if (PROBE_SEL >= 1 && PROBE_SEL <= 5) { unsigned long long acc = 0; for (int L = 0; L < 4; ++L) acc += st[1 + 5 * L + PROBE_SEL] - st[5 * L + PROBE_SEL]; v = (float)acc * 0.01f * 0.25f; }
        else if (PROBE_SEL == 6) v = (float)(tend - st[21]) * 0.01f;
        else v = (float)(tend - st[0]) * 0.01f * 0.1f;
        args.out[0] = v; } }
#endif
#ifdef PROBE_TWICE
    { unsigned char* wsb = args.ws; asm volatile("" : "+s"(wsb)); ++nbar; grid_bar((unsigned*)(wsb + WS_CTL) + 128, nbar * (unsigned)G); }
    run_all<32>(args, lds, G, bx, lo, hi, nbar, xbar);
#endif
}

extern "C" void kernel_launch(void* const* d_in, const int* in_sizes, int n_in, void* d_out, int out_size, void* d_ws, size_t ws_size, hipStream_t stream) {
    static int grid = 0;
    if (grid == 0) {
        if (n_in != 10 || ws_size < WS_END) { fprintf(stderr, "kernel_launch: need 10 inputs and >= %zu bytes of workspace (got %d, %zu)\n", (size_t)WS_END, n_in, ws_size); grid = -1; return; }
        int dev = 0, cus = 0, per_cu = 0;
        hipGetDevice(&dev); hipDeviceGetAttribute(&cus, hipDeviceAttributeMultiprocessorCount, dev);
        if (hipFuncSetAttribute((const void*)mega_fwd, hipFuncAttributeMaxDynamicSharedMemorySize, LDS_BYTES) != hipSuccess) { fprintf(stderr, "kernel_launch: hipFuncSetAttribute failed\n"); grid = -1; return; }
        if (hipOccupancyMaxActiveBlocksPerMultiprocessor(&per_cu, (const void*)mega_fwd, 512, LDS_BYTES) != hipSuccess || per_cu < 1) { fprintf(stderr, "kernel_launch: occupancy query gave %d\n", per_cu); per_cu = 1; }
        (void)hipGetLastError();
        grid = cus * per_cu;
    }
    if (grid < 0) return;
    if (hipMemsetAsync((char*)d_ws + WS_CTL, 0, WS_ZERO_BYTES, stream) != hipSuccess) { fprintf(stderr, "kernel_launch: memset failed\n"); return; }
    Args a{};
    a.x = (const float*)d_in[0]; a.meta = (const float*)d_in[1]; a.norm_gain = (const float*)d_in[2]; a.w_in = (const float*)d_in[3]; a.pool_w = (const float*)d_in[4];
    a.pool_scale = (const float*)d_in[5]; a.w_attn_up = (const float*)d_in[6]; a.w_pool_up = (const float*)d_in[7]; a.w_out = (const float*)d_in[8]; a.final_gain = (const float*)d_in[9];
    a.out = (float*)d_out; a.ws = (unsigned char*)d_ws;
#if MK_MULTI
    for (int ph = 0; ph < N_PHASES; ++ph) {
        if (ph >= 1 && ph < PH_FINAL && (ph - 1) % 5 == 0 && (ph - 1) / 5 == 0) continue;
        a.ph_lo = ph; a.ph_hi = ph + 1;
        hipLaunchKernelGGL(mega_fwd, dim3(grid), dim3(512), LDS_BYTES, stream, a);
    }
#else
    a.ph_lo = 0; a.ph_hi = N_PHASES;
    void* kargs[] = {&a};
    hipError_t e = hipLaunchCooperativeKernel((const void*)mega_fwd, dim3(grid), dim3(512), kargs, LDS_BYTES, stream);
    if (e != hipSuccess) fprintf(stderr, "cooperative launch failed: %s (grid %d)\n", hipGetErrorString(e), grid);
#endif
}
```
